# Optimizing an MI355X kernel written in HIP

```python
import jax, jax.numpy as jnp
from jax import lax
import numpy as np

D_MODEL = 1024
BATCH = 8
SEQ = 2048
DEPTH = 1

ATTN_HEADS = 8
KV_HEADS = 2
HEAD_DIM = 64
ATTN_WIDTH = ATTN_HEADS * HEAD_DIM
KV_WIDTH = KV_HEADS * HEAD_DIM
CONV_CHANNELS = D_MODEL - ATTN_WIDTH
MIX_WIDTH = ATTN_WIDTH + CONV_CHANNELS
IN_WIDTH = ATTN_WIDTH + 2 * KV_WIDTH + 2 * CONV_CHANNELS
CONV_KERNEL = 31
WINDOW = 128
BLOCK = 128
ROPE_THETA = 10000.0
PEER_HEADS = 8
N_KEYS = 128
N_EXPERTS = N_KEYS * N_KEYS
PEER_QDIM = 256
PEER_TOPK = 16
PEER_BLOCK = 128
EPS = 1e-6
NEG = -1e30

kernel_name = "hymba_conformer_swa_peer_block"


def rms_norm(x, g):
    xf = x.astype(jnp.float32)
    y = xf * lax.rsqrt(jnp.mean(xf * xf, axis=-1, keepdims=True) + EPS)
    return (y * g.astype(jnp.float32)).astype(x.dtype)


def layer_norm(x, g, b):
    xf = x.astype(jnp.float32)
    mu = jnp.mean(xf, axis=-1, keepdims=True)
    xc = xf - mu
    y = xc * lax.rsqrt(jnp.mean(xc * xc, axis=-1, keepdims=True) + EPS)
    return (y * g.astype(jnp.float32) + b.astype(jnp.float32)).astype(x.dtype)


def rope(x, pos):
    half = x.shape[-1] // 2
    inv = ROPE_THETA ** (-jnp.arange(half, dtype=jnp.float32) / half)
    ang = pos.astype(jnp.float32)[:, None] * inv[None, :]
    cos = jnp.cos(ang)[None, :, None, :]
    sin = jnp.sin(ang)[None, :, None, :]
    xf = x.astype(jnp.float32)
    x1, x2 = xf[..., :half], xf[..., half:]
    return jnp.concatenate([x1 * cos - x2 * sin, x2 * cos + x1 * sin], axis=-1).astype(x.dtype)


def sliding_window_attention(q, k, v, sinks):
    B, S, H, d = q.shape
    nb = S // BLOCK
    G = H // KV_HEADS
    qb = q.reshape(B, nb, BLOCK, KV_HEADS, G, d)
    kb = k.reshape(B, nb, BLOCK, KV_HEADS, d)
    vb = v.reshape(B, nb, BLOCK, KV_HEADS, d)
    pad = ((0, 0), (1, 0), (0, 0), (0, 0), (0, 0))
    kcat = jnp.concatenate([jnp.pad(kb, pad)[:, :-1], kb], axis=2)
    vcat = jnp.concatenate([jnp.pad(vb, pad)[:, :-1], vb], axis=2)
    s = jnp.einsum('bnqhgd,bnkhd->bnhgqk', qb, kcat).astype(jnp.float32) * (d ** -0.5)
    qi = jnp.arange(BLOCK)[:, None]
    kj = jnp.arange(2 * BLOCK)[None, :]
    rel = qi + BLOCK - kj
    band = (rel >= 0) & (rel < WINDOW)
    exists = (jnp.arange(nb)[:, None, None] > 0) | (kj[None] >= BLOCK)
    mask = band[None] & exists
    s = jnp.where(mask[None, :, None, None], s, NEG)
    sink = sinks.astype(jnp.float32).reshape(KV_HEADS, G)[None, None, :, :, None, None]
    m = jnp.maximum(jnp.max(s, axis=-1, keepdims=True), sink)
    p = jnp.exp(s - m)
    p = p / (jnp.sum(p, axis=-1, keepdims=True) + jnp.exp(sink - m))
    o = jnp.einsum('bnhgqk,bnkhd->bnqhgd', p.astype(v.dtype), vcat)
    return o.reshape(B, S, H * d)


def conformer_conv(a, b, conv_w, conv_b, ln_g, ln_b):
    C = a.shape[-1]
    u = a * jax.nn.sigmoid(b)
    up = jnp.pad(u, ((0, 0), (CONV_KERNEL - 1, 0), (0, 0)))
    y = lax.conv_general_dilated(up, conv_w[:, None, :].astype(u.dtype), window_strides=(1,),
                                 padding='VALID', dimension_numbers=('NWC', 'WIO', 'NWC'),
                                 feature_group_count=C) + conv_b
    return jax.nn.silu(layer_norm(y, ln_g, ln_b))


def peer_ffn(x, w_q, sub_keys, u_tab, v_tab):
    B, S, D = x.shape
    xt = x.reshape(-1, PEER_BLOCK, D)

    def block(xb):
        T = xb.shape[0]
        q = (xb @ w_q).reshape(T, PEER_HEADS, 2, PEER_QDIM // 2)
        s = jnp.einsum('thpc,hpkc->thpk', q, sub_keys).astype(jnp.float32)
        top_s, top_i = lax.top_k(s, PEER_TOPK)
        cand = top_s[:, :, 0, :, None] + top_s[:, :, 1, None, :]
        best_s, best_c = lax.top_k(cand.reshape(T, PEER_HEADS, PEER_TOPK * PEER_TOPK), PEER_TOPK)
        i1 = jnp.take_along_axis(top_i[:, :, 0], best_c // PEER_TOPK, axis=-1)
        i2 = jnp.take_along_axis(top_i[:, :, 1], best_c % PEER_TOPK, axis=-1)
        ids = i1 * N_KEYS + i2
        g = jax.nn.softmax(best_s, axis=-1)
        ue = u_tab[ids]
        ve = v_tab[ids]
        act = jax.nn.gelu(jnp.einsum('td,thkd->thk', xb, ue).astype(jnp.float32), approximate=False)
        w = (g * act).astype(xb.dtype)
        return jnp.einsum('thk,thkd->td', w, ve)

    return lax.map(block, xt).reshape(B, S, D)


def setup_inputs(seed: int = 0) -> dict:
    key = jax.random.key(seed)
    ks = jax.random.split(key, 20)
    f32 = jnp.float32
    L = DEPTH

    def gain(k, n):
        return (1.0 + 0.02 * jax.random.normal(k, (L, n), f32))

    return {
        "x": jax.random.normal(ks[0], (BATCH, SEQ, D_MODEL), f32),
        "norm_mix_g": gain(ks[1], D_MODEL),
        "w_in": jax.random.normal(ks[2], (L, D_MODEL, IN_WIDTH), f32) * D_MODEL ** -0.5,
        "conv_w": jax.random.normal(ks[3], (L, CONV_KERNEL, CONV_CHANNELS), f32) * CONV_KERNEL ** -0.5,
        "conv_b": 0.02 * jax.random.normal(ks[4], (L, CONV_CHANNELS), f32),
        "conv_ln_g": gain(ks[5], CONV_CHANNELS),
        "conv_ln_b": 0.02 * jax.random.normal(ks[6], (L, CONV_CHANNELS), f32),
        "attn_sinks": 0.5 * jax.random.normal(ks[7], (L, ATTN_HEADS), f32),
        "attn_out_g": gain(ks[8], ATTN_WIDTH),
        "conv_out_g": gain(ks[9], CONV_CHANNELS),
        "w_out": jax.random.normal(ks[10], (L, MIX_WIDTH, D_MODEL), f32) * (0.5 * MIX_WIDTH ** -0.5),
        "norm_ffn_g": gain(ks[11], D_MODEL),
        "peer_w_q": jax.random.normal(ks[12], (L, D_MODEL, PEER_HEADS * PEER_QDIM), f32) * D_MODEL ** -0.5,
        "peer_sub_keys": jax.random.normal(ks[13], (L, PEER_HEADS, 2, N_KEYS, PEER_QDIM // 2), f32) * (PEER_QDIM // 2) ** -0.5,
        "peer_u": jax.random.normal(ks[14], (L, N_EXPERTS, D_MODEL), f32) * D_MODEL ** -0.5,
        "peer_v": jax.random.normal(ks[15], (L, N_EXPERTS, D_MODEL), f32) * 0.5,
        "final_norm_g": (1.0 + 0.02 * jax.random.normal(ks[16], (D_MODEL,), f32)),
    }


def reference(x, norm_mix_g, w_in, conv_w, conv_b, conv_ln_g, conv_ln_b, attn_sinks,
              attn_out_g, conv_out_g, w_out, norm_ffn_g, peer_w_q, peer_sub_keys,
              peer_u, peer_v, final_norm_g):
    B, S, _ = x.shape
    pos = jnp.arange(S, dtype=jnp.int32)
    splits = [ATTN_WIDTH, ATTN_WIDTH + KV_WIDTH, ATTN_WIDTH + 2 * KV_WIDTH,
              ATTN_WIDTH + 2 * KV_WIDTH + CONV_CHANNELS]
    h = x
    for l in range(DEPTH):
        hn = rms_norm(h, norm_mix_g[l])
        proj = hn @ w_in[l]
        q, k, v, ga, gb = jnp.split(proj, splits, axis=-1)
        q = rope(q.reshape(B, S, ATTN_HEADS, HEAD_DIM), pos)
        k = rope(k.reshape(B, S, KV_HEADS, HEAD_DIM), pos)
        v = v.reshape(B, S, KV_HEADS, HEAD_DIM)
        attn = sliding_window_attention(q, k, v, attn_sinks[l])
        conv = conformer_conv(ga, gb, conv_w[l], conv_b[l], conv_ln_g[l], conv_ln_b[l])
        mixed = jnp.concatenate([rms_norm(attn, attn_out_g[l]), rms_norm(conv, conv_out_g[l])], axis=-1)
        h = h + mixed @ w_out[l]
        hn = rms_norm(h, norm_ffn_g[l])
        h = h + peer_ffn(hn, peer_w_q[l], peer_sub_keys[l], peer_u[l], peer_v[l])
    return rms_norm(h, final_norm_g)
```

```cpp
#include <hip/hip_runtime.h>
#include <stdint.h>

constexpr int BATCH = 8, SEQ = 2048, D = 1024, M = BATCH * SEQ;
constexpr int AH = 8, KVH = 2, HD = 64, AW = 512, KVW = 128, CC = 512, INW = 1792;
constexpr int CK = 31, WIN = 128;
constexpr int PH = 8, NK = 128, PQ = 256, TOPK = 16;
constexpr float EPS = 1e-6f;
constexpr int NT = 256;

constexpr size_t MiB = 1u << 20;
constexpr size_t WS_XN = 0;
constexpr size_t WS_PROJ = 64 * MiB;
constexpr size_t WS_MIX = 176 * MiB;
constexpr size_t WS_H = 0;
constexpr size_t WS_IDS = 64 * MiB;
constexpr size_t WS_GATE = 72 * MiB;
constexpr size_t WS_RSTD2 = 80 * MiB;
constexpr size_t WS_Q = 128 * MiB;

__device__ __forceinline__ float wave_sum(float v) {
#pragma unroll
    for (int o = 1; o < 64; o <<= 1) v += __shfl_xor(v, o);
    return v;
}

__global__ void __launch_bounds__(NT) k_rmsnorm(const float* __restrict__ x, const float* __restrict__ g, float* __restrict__ y) {
    const int lane = threadIdx.x & 63, wv = threadIdx.x >> 6;
    const int gw = blockIdx.x * (NT / 64) + wv, ngw = gridDim.x * (NT / 64);
    for (int r = gw; r < M; r += ngw) {
        const float4* xr = (const float4*)(x + (size_t)r * D);
        float4 v[4]; float s = 0.f;
#pragma unroll
        for (int j = 0; j < 4; ++j) { v[j] = xr[lane + 64 * j]; s += v[j].x * v[j].x + v[j].y * v[j].y + v[j].z * v[j].z + v[j].w * v[j].w; }
        s = wave_sum(s);
        const float rs = 1.0f / sqrtf(s * (1.0f / D) + EPS);
        float4* yr = (float4*)(y + (size_t)r * D);
#pragma unroll
        for (int j = 0; j < 4; ++j) { const float4 gg = ((const float4*)g)[lane + 64 * j];
            yr[lane + 64 * j] = make_float4(v[j].x * rs * gg.x, v[j].y * rs * gg.y, v[j].z * rs * gg.z, v[j].w * rs * gg.w); }
    }
}

__global__ void __launch_bounds__(NT) k_gemm(const float* __restrict__ A, const float* __restrict__ W, float* __restrict__ C, int N, int K,
                                              const float* __restrict__ rowscale, const float* __restrict__ kgain, const float* __restrict__ res) {
    __shared__ float As[16][68];
    __shared__ float Ws[16][64];
    const int t = threadIdx.x, tx = t & 15, ty = t >> 4;
    const int ntn = N / 64, ntiles = (M / 64) * ntn;
    for (int tile = blockIdx.x; tile < ntiles; tile += gridDim.x) {
        const int tm = tile / ntn, tn = tile % ntn;
        float acc[4][4];
#pragma unroll
        for (int i = 0; i < 4; ++i)
#pragma unroll
            for (int j = 0; j < 4; ++j) acc[i][j] = 0.f;
        const int ar = t >> 2, ak = (t & 3) * 4;
        const int wk = t >> 4, wn = (t & 15) * 4;
        const float rsA = rowscale ? rowscale[tm * 64 + ar] : 1.0f;
        for (int k0 = 0; k0 < K; k0 += 16) {
            float4 a = *(const float4*)(A + (size_t)(tm * 64 + ar) * K + k0 + ak);
            if (kgain) { const float4 gg = *(const float4*)(kgain + k0 + ak); a.x *= gg.x; a.y *= gg.y; a.z *= gg.z; a.w *= gg.w; }
            a.x *= rsA; a.y *= rsA; a.z *= rsA; a.w *= rsA;
            const float4 w = *(const float4*)(W + (size_t)(k0 + wk) * N + tn * 64 + wn);
            __syncthreads();
            As[ak + 0][ar] = a.x; As[ak + 1][ar] = a.y; As[ak + 2][ar] = a.z; As[ak + 3][ar] = a.w;
            *(float4*)&Ws[wk][wn] = w;
            __syncthreads();
#pragma unroll
            for (int kk = 0; kk < 16; ++kk) {
                const float4 av = *(const float4*)&As[kk][ty * 4];
                const float4 bv = *(const float4*)&Ws[kk][tx * 4];
                const float aa[4] = {av.x, av.y, av.z, av.w}, bb[4] = {bv.x, bv.y, bv.z, bv.w};
#pragma unroll
                for (int i = 0; i < 4; ++i)
#pragma unroll
                    for (int j = 0; j < 4; ++j) acc[i][j] += aa[i] * bb[j];
            }
        }
#pragma unroll
        for (int i = 0; i < 4; ++i) {
            const size_t off = (size_t)(tm * 64 + ty * 4 + i) * N + tn * 64 + tx * 4;
            float4 o = make_float4(acc[i][0], acc[i][1], acc[i][2], acc[i][3]);
            if (res) { const float4 r = *(const float4*)(res + off); o.x += r.x; o.y += r.y; o.z += r.z; o.w += r.w; }
            *(float4*)(C + off) = o;
        }
    }
}

__global__ void __launch_bounds__(NT) k_rope_glu(float* __restrict__ proj) {
    const size_t total = (size_t)M * (320 + 512);
    for (size_t i = (size_t)blockIdx.x * NT + threadIdx.x; i < total; i += (size_t)gridDim.x * NT) {
        const int r = (int)(i / 832), c = (int)(i % 832);
        float* row = proj + (size_t)r * INW;
        if (c < 320) {
            const int hh = c >> 5, ii = c & 31;
            const int pos = r % SEQ;
            const float inv = powf(10000.0f, -(float)ii / 32.0f);
            const float ang = (float)pos * inv;
            const float cs = cosf(ang), sn = sinf(ang);
            float* p = row + hh * 64 + ii;
            const float x1 = p[0], x2 = p[32];
            p[0] = x1 * cs - x2 * sn; p[32] = x2 * cs + x1 * sn;
        } else {
            const int ch = c - 320;
            const float a = row[768 + ch], b = row[1280 + ch];
            row[768 + ch] = a / (1.0f + expf(-b));
        }
    }
}

__global__ void __launch_bounds__(NT) k_attn(const float* __restrict__ proj, const float* __restrict__ sinks, const float* __restrict__ gain, float* __restrict__ attn_raw) {
    const int total = M * AH;
    for (int i = blockIdx.x * NT + threadIdx.x; i < total; i += gridDim.x * NT) {
        const int hq = i / M, r = i % M;
        const int pos = r % SEQ, kvh = hq / 4;
        const float* qp = proj + (size_t)r * INW + hq * 64;
        float q[64], o[64];
#pragma unroll
        for (int d = 0; d < 64; ++d) { q[d] = qp[d] * 0.125f; o[d] = 0.f; }
        float m = sinks[hq], l = 1.0f;
        const int lo = pos - (WIN - 1) < 0 ? 0 : pos - (WIN - 1);
        for (int kp = lo; kp <= pos; ++kp) {
            const float* kr = proj + (size_t)(r - pos + kp) * INW + 512 + kvh * 64;
            const float* vr = kr + 128;
            float s = 0.f;
#pragma unroll
            for (int d = 0; d < 64; ++d) s += q[d] * kr[d];
            const float mn = fmaxf(m, s);
            const float al = expf(m - mn), p = expf(s - mn);
            l = l * al + p;
#pragma unroll
            for (int d = 0; d < 64; ++d) o[d] = o[d] * al + p * vr[d];
            m = mn;
        }
        const float il = 1.0f / l;
        float* op = attn_raw + (size_t)r * D + hq * 64;
#pragma unroll
        for (int d = 0; d < 64; ++d) op[d] = o[d] * il;
    }
}

__global__ void __launch_bounds__(NT) k_attn_norm(float* __restrict__ mixed, const float* __restrict__ g) {
    const int lane = threadIdx.x & 63, wv = threadIdx.x >> 6;
    const int gw = blockIdx.x * (NT / 64) + wv, ngw = gridDim.x * (NT / 64);
    for (int r = gw; r < M; r += ngw) {
        float4* p = (float4*)(mixed + (size_t)r * D);
        float4 v[2]; float s = 0.f;
#pragma unroll
        for (int j = 0; j < 2; ++j) { v[j] = p[lane + 64 * j]; s += v[j].x * v[j].x + v[j].y * v[j].y + v[j].z * v[j].z + v[j].w * v[j].w; }
        s = wave_sum(s);
        const float rs = 1.0f / sqrtf(s * (1.0f / 512.0f) + EPS);
#pragma unroll
        for (int j = 0; j < 2; ++j) { const float4 gg = ((const float4*)g)[lane + 64 * j];
            p[lane + 64 * j] = make_float4(v[j].x * rs * gg.x, v[j].y * rs * gg.y, v[j].z * rs * gg.z, v[j].w * rs * gg.w); }
    }
}

__global__ void __launch_bounds__(NT) k_conv(const float* __restrict__ proj, const float* __restrict__ cw, const float* __restrict__ cb,
                                              const float* __restrict__ lng, const float* __restrict__ lnb, const float* __restrict__ og, float* __restrict__ mixed) {
    const int lane = threadIdx.x & 63, wv = threadIdx.x >> 6;
    const int gw = blockIdx.x * (NT / 64) + wv, ngw = gridDim.x * (NT / 64);
    for (int r = gw; r < M; r += ngw) {
        const int pos = r % SEQ;
        float y[8];
#pragma unroll
        for (int i = 0; i < 8; ++i) y[i] = cb[lane + 64 * i];
        for (int j = 0; j < CK; ++j) {
            const int tp = pos - (CK - 1) + j;
            if (tp < 0) continue;
            const float* ur = proj + (size_t)(r - pos + tp) * INW + 768;
#pragma unroll
            for (int i = 0; i < 8; ++i) y[i] += cw[j * CC + lane + 64 * i] * ur[lane + 64 * i];
        }
        float s = 0.f;
#pragma unroll
        for (int i = 0; i < 8; ++i) s += y[i];
        const float mu = wave_sum(s) * (1.0f / CC);
        float s2 = 0.f;
#pragma unroll
        for (int i = 0; i < 8; ++i) { y[i] -= mu; s2 += y[i] * y[i]; }
        const float rstd = 1.0f / sqrtf(wave_sum(s2) * (1.0f / CC) + EPS);
        float s3 = 0.f;
#pragma unroll
        for (int i = 0; i < 8; ++i) { const float z = y[i] * rstd * lng[lane + 64 * i] + lnb[lane + 64 * i]; const float a = z / (1.0f + expf(-z)); y[i] = a; s3 += a * a; }
        const float rs = 1.0f / sqrtf(wave_sum(s3) * (1.0f / CC) + EPS);
#pragma unroll
        for (int i = 0; i < 8; ++i) mixed[(size_t)r * D + 512 + lane + 64 * i] = y[i] * rs * og[lane + 64 * i];
    }
}

__global__ void __launch_bounds__(NT) k_rowrstd(const float* __restrict__ h, float* __restrict__ rstd) {
    const int lane = threadIdx.x & 63, wv = threadIdx.x >> 6;
    const int gw = blockIdx.x * (NT / 64) + wv, ngw = gridDim.x * (NT / 64);
    for (int r = gw; r < M; r += ngw) {
        const float4* xr = (const float4*)(h + (size_t)r * D);
        float s = 0.f;
#pragma unroll
        for (int j = 0; j < 4; ++j) { const float4 v = xr[lane + 64 * j]; s += v.x * v.x + v.y * v.y + v.z * v.z + v.w * v.w; }
        s = wave_sum(s);
        if (lane == 0) rstd[r] = 1.0f / sqrtf(s * (1.0f / D) + EPS);
    }
}

__device__ __forceinline__ void wave_argmax(float& v, int& idx) {
#pragma unroll
    for (int o = 1; o < 64; o <<= 1) {
        const float ov = __shfl_xor(v, o); const int oi = __shfl_xor(idx, o);
        if (ov > v || (ov == v && oi < idx)) { v = ov; idx = oi; }
    }
}
__global__ void __launch_bounds__(NT) k_topk(const float* __restrict__ q, const float* __restrict__ sk, int* __restrict__ ids, float* __restrict__ gate) {
    const int lane = threadIdx.x & 63, wv = threadIdx.x >> 6;
    const int gw = blockIdx.x * (NT / 64) + wv, ngw = gridDim.x * (NT / 64);
    const float NEGINF = -3.0e38f;
    for (int it = gw; it < M * PH; it += ngw) {
        const int r = it / PH, hh = it % PH;
        float ts[2]; int ti[2];
#pragma unroll
        for (int p = 0; p < 2; ++p) {
            const float* qs = q + (size_t)r * 2048 + hh * 256 + p * 128;
            const float* k0 = sk + ((size_t)(hh * 2 + p) * NK + lane) * 128;
            const float* k1 = k0 + 64 * 128;
            float s0 = 0.f, s1 = 0.f;
            for (int c = 0; c < 128; c += 4) {
                const float4 qq = *(const float4*)(qs + c);
                const float4 a = *(const float4*)(k0 + c), b = *(const float4*)(k1 + c);
                s0 += qq.x * a.x; s0 += qq.y * a.y; s0 += qq.z * a.z; s0 += qq.w * a.w;
                s1 += qq.x * b.x; s1 += qq.y * b.y; s1 += qq.z * b.z; s1 += qq.w * b.w;
            }
            float mys = NEGINF; int myi = 0;
            for (int rnk = 0; rnk < TOPK; ++rnk) {
                float v; int idx;
                if (s0 > s1 || (s0 == s1)) { v = s0; idx = lane; } else { v = s1; idx = lane + 64; }
                wave_argmax(v, idx);
                if (lane == rnk) { mys = v; myi = idx; }
                if (idx == lane) s0 = NEGINF;
                if (idx == lane + 64) s1 = NEGINF;
            }
            ts[p] = mys; ti[p] = myi;
        }
        float cv[4];
#pragma unroll
        for (int j = 0; j < 4; ++j) cv[j] = __shfl(ts[0], lane >> 2) + __shfl(ts[1], (lane & 3) * 4 + j);
        float bs = NEGINF; int bc = 0;
        for (int rnk = 0; rnk < TOPK; ++rnk) {
            float v = cv[0]; int idx = lane * 4;
#pragma unroll
            for (int j = 1; j < 4; ++j) if (cv[j] > v) { v = cv[j]; idx = lane * 4 + j; }
            wave_argmax(v, idx);
            if (lane == rnk) { bs = v; bc = idx; }
#pragma unroll
            for (int j = 0; j < 4; ++j) if (idx == lane * 4 + j) cv[j] = NEGINF;
        }
        const int i1 = __shfl(ti[0], bc >> 4), i2 = __shfl(ti[1], bc & 15);
        float mx = (lane < 16) ? bs : NEGINF;
#pragma unroll
        for (int o = 1; o < 16; o <<= 1) mx = fmaxf(mx, __shfl_xor(mx, o));
        float e = (lane < 16) ? expf(bs - mx) : 0.f;
        float sum = e;
#pragma unroll
        for (int o = 1; o < 16; o <<= 1) sum += __shfl_xor(sum, o);
        if (lane < 16) { ids[(size_t)r * 128 + hh * 16 + lane] = i1 * NK + i2; gate[(size_t)r * 128 + hh * 16 + lane] = e / sum; }
    }
}

__global__ void __launch_bounds__(NT) k_peer(const float* __restrict__ h, const float* __restrict__ rstd2, const float* __restrict__ gffn,
                                              const int* __restrict__ ids, const float* __restrict__ gate, const float* __restrict__ ut, const float* __restrict__ vt,
                                              const float* __restrict__ gfin, float* __restrict__ out) {
    const int lane = threadIdx.x & 63, wv = threadIdx.x >> 6;
    const int gw = blockIdx.x * (NT / 64) + wv, ngw = gridDim.x * (NT / 64);
    for (int r = gw; r < M; r += ngw) {
        const float4* hr = (const float4*)(h + (size_t)r * D);
        const float rs = rstd2[r];
        float4 hv[4], xn[4], acc[4];
#pragma unroll
        for (int j = 0; j < 4; ++j) { hv[j] = hr[lane + 64 * j]; const float4 gg = ((const float4*)gffn)[lane + 64 * j];
            xn[j] = make_float4(hv[j].x * rs * gg.x, hv[j].y * rs * gg.y, hv[j].z * rs * gg.z, hv[j].w * rs * gg.w); acc[j] = make_float4(0.f, 0.f, 0.f, 0.f); }
        for (int e = 0; e < 128; ++e) {
            const int id = ids[(size_t)r * 128 + e]; const float gw_ = gate[(size_t)r * 128 + e];
            const float4* ur = (const float4*)(ut + (size_t)id * D);
            const float4* vr = (const float4*)(vt + (size_t)id * D);
            float s = 0.f;
#pragma unroll
            for (int j = 0; j < 4; ++j) { const float4 u = ur[lane + 64 * j]; s += xn[j].x * u.x + xn[j].y * u.y + xn[j].z * u.z + xn[j].w * u.w; }
            s = wave_sum(s);
            const float act = 0.5f * s * (1.0f + erff(s * 0.70710678118654752f));
            const float w = gw_ * act;
#pragma unroll
            for (int j = 0; j < 4; ++j) { const float4 v = vr[lane + 64 * j]; acc[j].x += w * v.x; acc[j].y += w * v.y; acc[j].z += w * v.z; acc[j].w += w * v.w; }
        }
        float s = 0.f;
#pragma unroll
        for (int j = 0; j < 4; ++j) { acc[j].x += hv[j].x; acc[j].y += hv[j].y; acc[j].z += hv[j].z; acc[j].w += hv[j].w;
            s += acc[j].x * acc[j].x + acc[j].y * acc[j].y + acc[j].z * acc[j].z + acc[j].w * acc[j].w; }
        s = wave_sum(s);
        const float rf = 1.0f / sqrtf(s * (1.0f / D) + EPS);
        float4* orow = (float4*)(out + (size_t)r * D);
#pragma unroll
        for (int j = 0; j < 4; ++j) { const float4 gg = ((const float4*)gfin)[lane + 64 * j];
            orow[lane + 64 * j] = make_float4(acc[j].x * rf * gg.x, acc[j].y * rf * gg.y, acc[j].z * rf * gg.z, acc[j].w * rf * gg.w); }
    }
}

extern "C" void kernel_launch(void* const* d_in, const int* in_sizes, int n_in, void* d_out, int out_size, void* d_ws, size_t ws_size, hipStream_t stream) {
    const float* x = (const float*)d_in[0];
    const float* norm_mix_g = (const float*)d_in[1];
    const float* w_in = (const float*)d_in[2];
    const float* conv_w = (const float*)d_in[3];
    const float* conv_b = (const float*)d_in[4];
    const float* conv_ln_g = (const float*)d_in[5];
    const float* conv_ln_b = (const float*)d_in[6];
    const float* attn_sinks = (const float*)d_in[7];
    const float* attn_out_g = (const float*)d_in[8];
    const float* conv_out_g = (const float*)d_in[9];
    const float* w_out = (const float*)d_in[10];
    const float* norm_ffn_g = (const float*)d_in[11];
    const float* peer_w_q = (const float*)d_in[12];
    const float* peer_sub_keys = (const float*)d_in[13];
    const float* peer_u = (const float*)d_in[14];
    const float* peer_v = (const float*)d_in[15];
    const float* final_norm_g = (const float*)d_in[16];
    char* ws = (char*)d_ws;
    float* xn = (float*)(ws + WS_XN);
    float* proj = (float*)(ws + WS_PROJ);
    float* mixed = (float*)(ws + WS_MIX);
    float* h = (float*)(ws + WS_H);
    int* ids = (int*)(ws + WS_IDS);
    float* gate = (float*)(ws + WS_GATE);
    float* rstd2 = (float*)(ws + WS_RSTD2);
    float* q = (float*)(ws + WS_Q);
    float* out = (float*)d_out;
    const int G = 2048;
    k_rmsnorm<<<G, NT, 0, stream>>>(x, norm_mix_g, xn);
    k_gemm<<<G, NT, 0, stream>>>(xn, w_in, proj, INW, D, nullptr, nullptr, nullptr);
    k_rope_glu<<<G, NT, 0, stream>>>(proj);
    k_attn<<<G, NT, 0, stream>>>(proj, attn_sinks, attn_out_g, mixed);
    k_attn_norm<<<G, NT, 0, stream>>>(mixed, attn_out_g);
    k_conv<<<G, NT, 0, stream>>>(proj, conv_w, conv_b, conv_ln_g, conv_ln_b, conv_out_g, mixed);
    k_gemm<<<G, NT, 0, stream>>>(mixed, w_out, h, D, D, nullptr, nullptr, x);
    k_rowrstd<<<G, NT, 0, stream>>>(h, rstd2);
    k_gemm<<<G, NT, 0, stream>>>(h, peer_w_q, q, 2048, D, rstd2, norm_ffn_g, nullptr);
    k_topk<<<G, NT, 0, stream>>>(q, peer_sub_keys, ids, gate);
    k_peer<<<G, NT, 0, stream>>>(h, rstd2, norm_ffn_g, ids, gate, peer_u, peer_v, final_norm_g, out);
}
```

```cpp
#include <hip/hip_runtime.h>
#include <cstdio>
#include <cstdint>
namespace pg8 {
#define PG8_LAS __attribute__((address_space(3)))
typedef unsigned short bf16_t;
typedef short bf16x8 __attribute__((ext_vector_type(8)));
typedef float f32x4 __attribute__((ext_vector_type(4)));
typedef unsigned u32x4 __attribute__((ext_vector_type(4)));
constexpr int BM = 256, BK = 64, HALF = 128, HTB = HALF * BK * 2  , STAGE_BYTES = 8 * HTB, NXCD = 8, WGM = 8;

__host__ __device__ __forceinline__ int lds_byte(int r, int c) { const int st = (r >> 4) * 2 + (c >> 5), rr = r & 15, cc = c & 31, ob = rr * 64 + cc * 2; return st * 1024 + (ob ^ (((ob >> 9) & 1) << 5)); }
__host__ __device__ __forceinline__ void stage_rc(int b, int& R, int& C) { const int st = b / 1024, sb = b % 1024, swz = sb ^ (((sb >> 9) & 1) << 5); R = (st >> 1) * 16 + swz / 64; C = (st & 1) * 32 + (swz % 64) / 2; }
__host__ __device__ __forceinline__ int perm32(int rho) { const int n = rho >> 4, i = rho & 15; return 8 * (i >> 2) + 4 * n + (i & 3); }

struct Unit { int pm, pn, idx; };
struct Gemm { const bf16_t* A; const bf16_t* Bt; int M, N, K; };

struct StaticOrder {
    int nM, nN, nwg, G, c;
    __host__ __device__ void init(int M, int N, int G_, int c_) { nM = M / BM; nN = N / BM; nwg = nM * nN; G = G_; c = c_; }
    __host__ __device__ bool next(int i, Unit& u) const {
        const long L = (long)i * G + c; if (L >= nwg) return false;
        int wgid = (int)L; { const int q = nwg / NXCD, r = nwg % NXCD, xcd = wgid % NXCD, off = wgid / NXCD; wgid = (xcd < r ? xcd * (q + 1) : r * (q + 1) + (xcd - r) * q) + off; }
        const int nig = WGM * nN, gid = wgid / nig, fm = gid * WGM, gsz = (nM - fm) < WGM ? (nM - fm) : WGM;
        u.pm = fm + ((wgid % nig) % gsz); u.pn = (wgid % nig) / gsz; u.idx = i; return true;
    }
    __device__ __forceinline__ void a_ready(const Unit&) const {}
    __device__ __forceinline__ void done(const Unit&) const {}
};

__device__ __forceinline__ unsigned cvt_pk_bf16(float lo, float hi) { unsigned r; asm volatile("v_cvt_pk_bf16_f32 %0, %1, %2" : "=v"(r) : "v"(lo), "v"(hi)); return r; }
typedef float f32x2 __attribute__((ext_vector_type(2)));
template <class Epi, class Sched, bool ALIGN_EPI = false, bool SP2 = false>
__device__ __forceinline__ void gemm_phase(PG8_LAS unsigned char* lds, const Gemm g, const Sched& S, const Epi& E) {
    const int tid = threadIdx.x, wid = __builtin_amdgcn_readfirstlane(tid >> 6), lane = tid & 63, wr = wid >> 2, wc = wid & 3, fr = lane & 15, fq = lane >> 4;
    const int K = g.K, nt = K / BK;
    unsigned voffA[2], voffB[2];
#pragma unroll
    for (int i = 0; i < 2; ++i) { int R, C; stage_rc(tid * 16 + i * 8192, R, C); const int Rb = Epi::PERM ? ((R & ~31) + perm32(R & 31)) : R;
        voffA[i] = (unsigned)(R * K + C) * 2u; voffB[i] = (unsigned)(Rb * K + C) * 2u; }
    const size_t kstep = (size_t)(BK * 2);
    const size_t hstep = (size_t)HALF * K * 2;
    const size_t tstep = 2 * hstep;
    const unsigned ldsw = (unsigned)wid * 1024u;
    const int aoff = lds_byte(wr * 64 + fr, fq * 8), boff = lds_byte(wc * 32 + fr, fq * 8);
#define PG8_SA(b, h) (((b) * 2 + (h)) * HTB)
#define PG8_SB(b, h) ((4 + (b) * 2 + (h)) * HTB)
#define PG8_STAGE(bufoff, gbase, voff) do { _Pragma("unroll") for (int _i = 0; _i < 2; ++_i) \
        __builtin_amdgcn_global_load_lds((const unsigned*)((const char*)(gbase) + (voff)[_i]), (PG8_LAS unsigned*)(lds + (bufoff) + ldsw + _i * 8192), 16, 0, 0); } while (0)
#define PG8_LDA(dst, b, h) do { _Pragma("unroll") for (int m = 0; m < 4; ++m) _Pragma("unroll") for (int k = 0; k < 2; ++k) dst[m][k] = *(const PG8_LAS bf16x8*)(lds + PG8_SA(b, h) + aoff + m * 2048 + k * 1024); } while (0)
#define PG8_LDB(dst, b, h) do { _Pragma("unroll") for (int n = 0; n < 2; ++n) _Pragma("unroll") for (int k = 0; k < 2; ++k) dst[n][k] = *(const PG8_LAS bf16x8*)(lds + PG8_SB(b, h) + boff + n * 2048 + k * 1024); } while (0)
#define PG8_MMA(ai, bj, At, Bt) do { __builtin_amdgcn_s_setprio(1); _Pragma("unroll") for (int m = 0; m < 4; ++m) _Pragma("unroll") for (int n = 0; n < 2; ++n) _Pragma("unroll") for (int k = 0; k < 2; ++k) \
        acc[ai][bj][m][n] = __builtin_amdgcn_mfma_f32_16x16x32_bf16(Bt[n][k], At[m][k], acc[ai][bj][m][n], 0, 0, 0); __builtin_amdgcn_s_setprio(0); } while (0)
#define PG8_WAIT_V(n) asm volatile("s_waitcnt vmcnt(" #n ")" ::: "memory")
#define PG8_WAIT_L(n) asm volatile("s_waitcnt lgkmcnt(" #n ")" ::: "memory")
#define PG8_BAR __builtin_amdgcn_s_barrier()
#define PG8_SCHED __builtin_amdgcn_sched_barrier(0)
    Unit cur, nxt; int ui = 0;
    if (!S.next(0, cur)) return;
    f32x4 acc[2][2][4][2];
#pragma unroll
    for (int a = 0; a < 2; ++a)
#pragma unroll
        for (int b = 0; b < 2; ++b)
#pragma unroll
            for (int m = 0; m < 4; ++m)
#pragma unroll
                for (int n = 0; n < 2; ++n) acc[a][b][m][n] = (f32x4){0.f, 0.f, 0.f, 0.f};
    bf16x8 At[4][2], B0[2][2], B1[2][2];
    const char* cA = (const char*)g.A + (size_t)cur.pm * tstep; const char* cB = (const char*)g.Bt + (size_t)cur.pn * tstep;
    S.a_ready(cur);
    if constexpr (SP2) {
        PG8_STAGE(PG8_SB(0, 0), cB, voffB); PG8_STAGE(PG8_SB(0, 1), cB + hstep, voffB); PG8_STAGE(PG8_SA(0, 0), cA, voffA); PG8_STAGE(PG8_SA(0, 1), cA + hstep, voffA);
        if (wr == 1) PG8_BAR;
        PG8_WAIT_V(2); PG8_BAR;
        PG8_STAGE(PG8_SB(1, 0), cB + kstep, voffB); PG8_STAGE(PG8_SA(1, 0), cA + kstep, voffA); PG8_STAGE(PG8_SB(1, 1), cB + hstep + kstep, voffB);
        PG8_WAIT_V(6); PG8_BAR;
    } else {
        PG8_STAGE(PG8_SB(0, 0), cB, voffB); PG8_STAGE(PG8_SA(0, 0), cA, voffA); PG8_STAGE(PG8_SB(0, 1), cB + hstep, voffB); PG8_STAGE(PG8_SA(0, 1), cA + hstep, voffA);
        if (wr == 1) PG8_BAR;
        PG8_WAIT_V(4); PG8_BAR;
        PG8_STAGE(PG8_SB(1, 0), cB + kstep, voffB); PG8_STAGE(PG8_SA(1, 0), cA + kstep, voffA); PG8_STAGE(PG8_SB(1, 1), cB + hstep + kstep, voffB);
        PG8_WAIT_V(6); PG8_BAR;
    }
    for (;;) {
        const bool has_next = S.next(ui + 1, nxt);
        const char* nA = has_next ? (const char*)g.A + (size_t)nxt.pm * tstep : cA; const char* nB = has_next ? (const char*)g.Bt + (size_t)nxt.pn * tstep : cB;
        for (int t = 0; t < nt; t += 2) {
            const bool last = (t == nt - 2);
            const char* a1 = cA + (size_t)(t + 1) * kstep;
            const char* a2 = last ? nA : cA + (size_t)(t + 2) * kstep; const char* b2 = last ? nB : cB + (size_t)(t + 2) * kstep;
            const char* a3 = a2 + kstep; const char* b3 = b2 + kstep;
            if (last && has_next) S.a_ready(nxt);
            if constexpr (SP2) {
            PG8_LDB(B0, 0, 0); PG8_LDB(B1, 0, 1); PG8_SCHED; PG8_LDA(At, 0, 0); PG8_STAGE(PG8_SA(1, 1), a1 + hstep, voffA);
            PG8_WAIT_V(8); PG8_WAIT_L(0); PG8_BAR; PG8_MMA(0, 0, At, B0); PG8_MMA(0, 1, At, B1); PG8_BAR; PG8_SCHED;
            PG8_LDA(At, 0, 1); PG8_STAGE(PG8_SB(0, 0), b2, voffB); PG8_STAGE(PG8_SB(0, 1), b2 + hstep, voffB); PG8_STAGE(PG8_SA(0, 0), a2, voffA);
            PG8_WAIT_V(8); PG8_WAIT_L(0); PG8_BAR; PG8_MMA(1, 0, At, B0); PG8_MMA(1, 1, At, B1); PG8_BAR; PG8_SCHED;
            PG8_LDB(B0, 1, 0); PG8_LDB(B1, 1, 1); PG8_SCHED; PG8_LDA(At, 1, 0); PG8_STAGE(PG8_SA(0, 1), a2 + hstep, voffA);
            PG8_WAIT_V(8); PG8_WAIT_L(0); PG8_BAR; PG8_MMA(0, 0, At, B0); PG8_MMA(0, 1, At, B1); PG8_BAR; PG8_SCHED;
            PG8_LDA(At, 1, 1); PG8_STAGE(PG8_SB(1, 0), b3, voffB); PG8_STAGE(PG8_SB(1, 1), b3 + hstep, voffB); PG8_STAGE(PG8_SA(1, 0), a3, voffA);
            PG8_WAIT_V(8); PG8_WAIT_L(0); PG8_BAR; PG8_MMA(1, 0, At, B0); PG8_MMA(1, 1, At, B1); PG8_BAR; PG8_SCHED;
            } else {
            PG8_LDB(B0, 0, 0); PG8_SCHED; PG8_LDA(At, 0, 0); PG8_STAGE(PG8_SA(1, 1), a1 + hstep, voffA);
            PG8_WAIT_L(8); PG8_BAR; PG8_WAIT_L(0); PG8_MMA(0, 0, At, B0); PG8_BAR; PG8_SCHED;
            PG8_LDB(B1, 0, 1); PG8_STAGE(PG8_SB(0, 0), b2, voffB);
            PG8_BAR; PG8_WAIT_L(0); PG8_MMA(0, 1, At, B1); PG8_BAR;
            PG8_LDA(At, 0, 1); PG8_STAGE(PG8_SA(0, 0), a2, voffA);
            PG8_BAR; PG8_WAIT_L(0); PG8_MMA(1, 0, At, B0); PG8_BAR; PG8_SCHED;
            PG8_STAGE(PG8_SB(0, 1), b2 + hstep, voffB);
            PG8_WAIT_V(6); PG8_BAR; PG8_MMA(1, 1, At, B1); PG8_BAR;
            PG8_LDB(B0, 1, 0); PG8_SCHED; PG8_LDA(At, 1, 0); PG8_STAGE(PG8_SA(0, 1), a2 + hstep, voffA);
            PG8_WAIT_L(8); PG8_BAR; PG8_WAIT_L(0); PG8_MMA(0, 0, At, B0); PG8_BAR; PG8_SCHED;
            PG8_LDB(B1, 1, 1); PG8_STAGE(PG8_SB(1, 0), b3, voffB);
            PG8_BAR; PG8_WAIT_L(0); PG8_MMA(0, 1, At, B1); PG8_BAR;
            PG8_LDA(At, 1, 1); PG8_STAGE(PG8_SA(1, 0), a3, voffA);
            PG8_BAR; PG8_WAIT_L(0); PG8_MMA(1, 0, At, B0); PG8_BAR; PG8_SCHED;
            PG8_STAGE(PG8_SB(1, 1), b3 + hstep, voffB);
            PG8_WAIT_V(6); PG8_BAR; PG8_MMA(1, 1, At, B1); PG8_BAR;
            }
        }
        if constexpr (ALIGN_EPI) { if (wr == 0) PG8_BAR; }
        if constexpr (!Epi::AFTER_DRAIN) { E(acc, cur, wr, wc, fr, fq); S.done(cur); }
        if (!has_next) break;
#pragma unroll
        for (int a = 0; a < 2; ++a)
#pragma unroll
            for (int b = 0; b < 2; ++b)
#pragma unroll
                for (int m = 0; m < 4; ++m)
#pragma unroll
                    for (int n = 0; n < 2; ++n) acc[a][b][m][n] = (f32x4){0.f, 0.f, 0.f, 0.f};
        cur = nxt; cA = nA; cB = nB; ++ui;
        if constexpr (ALIGN_EPI) { if (wr == 1) PG8_BAR; }
    }
    PG8_WAIT_V(0);
    if constexpr (!ALIGN_EPI) { if (wr == 0) PG8_BAR; }
    PG8_BAR;
    if constexpr (Epi::AFTER_DRAIN) { E.fused(acc, cur, wr, wc, fr, fq, lds, wid, lane); S.done(cur); }
#undef PG8_SA
#undef PG8_SB
#undef PG8_STAGE
#undef PG8_LDA
#undef PG8_LDB
#undef PG8_MMA
#undef PG8_WAIT_V
#undef PG8_WAIT_L
#undef PG8_BAR
#undef PG8_SCHED
}
}

#define REP0 1
#define REP1 1
#define REP2 1
#define REP3 1
#define REP4 1
#define REP5 1
#define REPTK 1
#define LAS __attribute__((address_space(3)))
typedef unsigned short bf16;
typedef float f32x2 __attribute__((ext_vector_type(2)));
typedef float f32x4 __attribute__((ext_vector_type(4)));
typedef unsigned u32x2 __attribute__((ext_vector_type(2)));
typedef unsigned u32x4 __attribute__((ext_vector_type(4)));

constexpr int BATCH = 8, SEQ = 2048, D = 1024, M = BATCH * SEQ;
constexpr int INW = 1792, CC = 512, CK = 31, WIN = 128;
constexpr int NK = 128, TOPK = 16, NE = 16384;
constexpr int TAB_P1 = 10240;
constexpr float EPS = 1e-6f;
constexpr int NT = 512, NWAVES = 8;
constexpr int LDS_BYTES = 147456;
constexpr int MISC_OFF = 131072 + 64;

constexpr size_t MiB = 1u << 20;
constexpr size_t WS_CTL = 0;
constexpr size_t CTL_ZERO_BYTES = 32768;
constexpr size_t WS_W1T = 2 * MiB;
constexpr size_t WS_W2T = 6 * MiB;
constexpr size_t WS_W3T = 8 * MiB;
constexpr size_t WS_ROPE = 12 * MiB;
constexpr size_t WS_SCL = 13 * MiB;
constexpr size_t WS_U8 = 16 * MiB;
constexpr size_t WS_V8 = 32 * MiB;
constexpr size_t WS_XN = 48 * MiB;
constexpr size_t WS_MIX = 120 * MiB;
constexpr size_t WS_RSTD1 = 14 * MiB;
constexpr size_t WS_Q = 80 * MiB;
constexpr size_t WS_K = 96 * MiB;
constexpr size_t WS_V = 100 * MiB;
constexpr size_t WS_UB = 104 * MiB;
constexpr size_t WS_HB = 184 * MiB;
constexpr size_t WS_IDS = 216 * MiB;
constexpr size_t WS_META = 224 * MiB;
constexpr size_t WS_SC = 48 * MiB;
constexpr size_t WS_SC1 = 112 * MiB;

typedef __bf16 bf16x2_t __attribute__((ext_vector_type(2)));
__device__ __forceinline__ unsigned pk2(float lo, float hi) { const f32x2 v = {lo, hi}; return __builtin_bit_cast(unsigned, __builtin_convertvector(v, bf16x2_t)); }
__device__ __forceinline__ unsigned f2bf(float f) { return pk2(f, 0.f) & 0xffffu; }
__device__ __forceinline__ float bflo(unsigned w) { return __builtin_bit_cast(float, w << 16); }
__device__ __forceinline__ float bfhi(unsigned w) { return __builtin_bit_cast(float, w & 0xffff0000u); }
__device__ __forceinline__ float wave_sum(float v) {
#pragma unroll
    for (int o = 1; o < 64; o <<= 1) v += __shfl_xor(v, o);
    return v;
}
__device__ __forceinline__ void wave_sum4(float (&v)[4]) {
#pragma unroll
    for (int o = 1; o < 64; o <<= 1) { float t[4];
#pragma unroll
        for (int i = 0; i < 4; ++i) t[i] = __shfl_xor(v[i], o);
#pragma unroll
        for (int i = 0; i < 4; ++i) v[i] += t[i]; }
}

struct EpiProj {
    static constexpr bool PERM = true, AFTER_DRAIN = false;
    bf16 *Q, *K, *V, *U; const float *ctab, *stab, *rstd;
    __device__ __forceinline__ void operator()(const pg8::f32x4 (&acc)[2][2][4][2], const pg8::Unit& u, int wr, int wc, int fr, int fq) const {
        const int pn = u.pn, row0 = u.pm * 256 + wr * 64 + fr;
        if (pn <= 2) {
#pragma unroll
            for (int bj = 0; bj < 2; ++bj) {
                if (pn == 2 && bj == 1) {
#pragma unroll
                    for (int ai = 0; ai < 2; ++ai)
#pragma unroll
                        for (int m = 0; m < 4; ++m) {
                            const int row = row0 + ai * 128 + m * 16, bb = row >> 11, s = row & (SEQ - 1);
                            const float rsr = rstd[row];
#pragma unroll
                            for (int n = 0; n < 2; ++n) { const pg8::f32x4 a = acc[ai][1][m][n] * rsr;
                                bf16* vp = V + ((size_t)(bb * 2 + (wc >> 1)) * 64 + (wc & 1) * 32 + fq * 8 + n * 4) * SEQ + s;
#pragma unroll
                                for (int j = 0; j < 4; ++j) vp[(size_t)j * SEQ] = (bf16)f2bf(a[j]); }
                        }
                } else {
                    bf16* base; int ld, colh; float sc;
                    if (pn < 2) { base = Q; ld = 512; colh = (4 * pn + 2 * bj + (wc >> 1)) * 64; sc = 0.125f * 1.44269504089f; }
                    else { base = K; ld = 128; colh = (wc >> 1) * 64; sc = 1.0f; }
                    const int i0 = 16 * (wc & 1) + 4 * fq;
#pragma unroll
                    for (int ai = 0; ai < 2; ++ai)
#pragma unroll
                        for (int m = 0; m < 4; ++m) {
                            const int row = row0 + ai * 128 + m * 16, pos = row & (SEQ - 1);
                            const pg8::f32x4 c = *(const pg8::f32x4*)(ctab + pos * 32 + i0), s = *(const pg8::f32x4*)(stab + pos * 32 + i0);
                            const pg8::f32x4 x1 = acc[ai][bj][m][0], x2 = acc[ai][bj][m][1];
                            const float scr = sc * rstd[row];
                            const pg8::f32x4 o1 = (x1 * c - x2 * s) * scr, o2 = (x2 * c + x1 * s) * scr;
                            u32x2 w1, w2; w1.x = pk2(o1[0], o1[1]); w1.y = pk2(o1[2], o1[3]); w2.x = pk2(o2[0], o2[1]); w2.y = pk2(o2[2], o2[3]);
                            bf16* p = base + (size_t)row * ld + colh + i0;
                            *(u32x2*)p = w1; *(u32x2*)(p + 32) = w2;
                        }
                }
            }
        } else {
            const int ch0 = 128 * (pn - 3) + 32 * wc + 8 * fq;
#pragma unroll
            for (int ai = 0; ai < 2; ++ai)
#pragma unroll
                for (int m = 0; m < 4; ++m) {
                    const float rsr = rstd[row0 + ai * 128 + m * 16];
                    float o[8];
#pragma unroll
                    for (int n = 0; n < 2; ++n) {
                        const pg8::f32x4 a = acc[ai][0][m][n] * rsr, b = acc[ai][1][m][n] * rsr;
#pragma unroll
                        for (int j = 0; j < 4; ++j) o[4 * n + j] = a[j] * __builtin_amdgcn_rcpf(1.0f + __builtin_amdgcn_exp2f(b[j] * -1.44269504089f));
                    }
                    u32x4 w; w.x = pk2(o[0], o[1]); w.y = pk2(o[2], o[3]); w.z = pk2(o[4], o[5]); w.w = pk2(o[6], o[7]);
                    *(u32x4*)(U + (size_t)(row0 + ai * 128 + m * 16) * 512 + ch0) = w;
                }
        }
    }
};
struct EpiRes {
    static constexpr bool PERM = true, AFTER_DRAIN = false;
    const bf16* x; bf16* HB;
    __device__ __forceinline__ void operator()(const pg8::f32x4 (&acc)[2][2][4][2], const pg8::Unit& u, int wr, int wc, int fr, int fq) const {
        const int row0 = u.pm * 256 + wr * 64 + fr, col0 = u.pn * 256 + wc * 32 + fq * 8;
#pragma unroll
        for (int ai = 0; ai < 2; ++ai)
#pragma unroll
            for (int m = 0; m < 4; ++m)
#pragma unroll
                for (int bj = 0; bj < 2; ++bj) {
                    const size_t off = (size_t)(row0 + ai * 128 + m * 16) * D + col0 + bj * 128;
                    const u32x4 xw = *(const u32x4*)(x + off);
                    const pg8::f32x4 o0 = (pg8::f32x4){bflo(xw.x), bfhi(xw.x), bflo(xw.y), bfhi(xw.y)} + acc[ai][bj][m][0];
                    const pg8::f32x4 o1 = (pg8::f32x4){bflo(xw.z), bfhi(xw.z), bflo(xw.w), bfhi(xw.w)} + acc[ai][bj][m][1];
                    u32x4 w; w.x = pk2(o0[0], o0[1]); w.y = pk2(o0[2], o0[3]); w.z = pk2(o1[0], o1[1]); w.w = pk2(o1[2], o1[3]);
                    *(u32x4*)(HB + off) = w;
                }
    }
};
struct EpiScore {
    static constexpr bool PERM = false, AFTER_DRAIN = false;
    float* slot0; float* slot1;
    __device__ __forceinline__ void operator()(const pg8::f32x4 (&acc)[2][2][4][2], const pg8::Unit& u, int wr, int wc, int fr, int fq) const {
        const __amdgpu_buffer_rsrc_t rs = __builtin_amdgcn_make_buffer_rsrc((void*)(u.idx ? slot1 : slot0), (short)0, 2 * 32 * 256 * 16, 0x00020000);
        const int voff = wc * 32768 + fq * 4096 + wr * 1024 + fr * 16;
#pragma unroll
        for (int ai = 0; ai < 2; ++ai)
#pragma unroll
            for (int m = 0; m < 4; ++m)
#pragma unroll
                for (int bj = 0; bj < 2; ++bj)
#pragma unroll
                    for (int n = 0; n < 2; ++n)
                        __builtin_amdgcn_raw_buffer_store_b128(__builtin_bit_cast(u32x4, acc[ai][bj][m][n]), rs, voff, bj * 131072 + n * 16384 + ai * 2048 + m * 256, 0);
    }
};
struct RoundOrder {
    pg8::StaticOrder S; int round;
    __device__ bool next(int i, pg8::Unit& u) const { return i == 0 && S.next(round, u); }
    __device__ __forceinline__ void a_ready(const pg8::Unit&) const {}
    __device__ __forceinline__ void done(const pg8::Unit&) const {}
};

__device__ __forceinline__ int swap45(int v) { return (v & ~48) | ((v & 16) << 1) | ((v & 32) >> 1); }
__device__ __forceinline__ int w1_src_col(int p) {
    if (p < 640) { const int pp = p & 63, w = pp >> 5, q = pp & 31;
        return (p & ~63) | (32 * ((q >> 2) & 1) + 16 * w + 4 * (q >> 3) + (q & 3)); }
    if (p < 768) return p;
    const int t = (p - 768) >> 8, c = (p - 768) & 255;
    return ((c & 128) ? 1280 : 768) + 128 * t + (c & 127);
}
template <int MODE>
__device__ __forceinline__ void p0_transpose(const float* __restrict__ W, int nsrc, int nrows, bf16* __restrict__ WT, const float* __restrict__ g0, const float* __restrict__ g1, int gtid, int gthreads) {
    const int total = nrows * 128;
    for (int it = gtid; it < total; it += gthreads) {
        const int p = it % nrows, kc = it / nrows, L = (MODE == 0) ? w1_src_col(p) : p;
        float v[8];
#pragma unroll
        for (int j = 0; j < 8; ++j) { const int k = kc * 8 + j; float a = W[(size_t)k * nsrc + L];
            if (MODE == 1) a *= (k < 512) ? g0[k] : g1[k - 512];
            else a *= g0[k];
            v[j] = a; }
        u32x4 o; o.x = pk2(v[0], v[1]); o.y = pk2(v[2], v[3]); o.z = pk2(v[4], v[5]); o.w = pk2(v[6], v[7]);
        *(u32x4*)(WT + (size_t)p * D + kc * 8) = o;
    }
}
typedef float f32x16 __attribute__((ext_vector_type(16)));
__device__ __forceinline__ void p0_fold_item(const float* __restrict__ wq, const float* __restrict__ sk, const float* __restrict__ gffn, bf16* __restrict__ W3T, int item, float* lds) {
    const int hp = item >> 4, k0 = (item & 15) * 64, t = threadIdx.x, lane = t & 63, wave = t >> 6;
    float* sks = lds;
    float* wqs = lds + 128 * 129;
    for (int i = t; i < 128 * 32; i += NT) { const int key = i >> 5, c4 = i & 31;
        const float4 v = *(const float4*)(sk + ((size_t)hp * 128 + key) * 128 + c4 * 4); float* d = sks + key * 129 + c4 * 4; d[0] = v.x; d[1] = v.y; d[2] = v.z; d[3] = v.w; }
    for (int i = t; i < 64 * 32; i += NT) { const int kk = i >> 5, c4 = i & 31;
        const float4 v = *(const float4*)(wq + (size_t)(k0 + kk) * 2048 + hp * 128 + c4 * 4); float* d = wqs + kk * 129 + c4 * 4; d[0] = v.x; d[1] = v.y; d[2] = v.z; d[3] = v.w; }
    __syncthreads();
    const int ti = wave >> 2, tj = wave & 3, l31 = lane & 31, lh = lane >> 5;
    const float* ap = wqs + (32 * ti + l31) * 129 + lh;
    const float* bp = sks + (32 * tj + l31) * 129 + lh;
    f32x16 acc;
#pragma unroll
    for (int i = 0; i < 16; ++i) acc[i] = 0.f;
#pragma unroll 8
    for (int s = 0; s < 64; ++s) acc = __builtin_amdgcn_mfma_f32_32x32x2f32(ap[2 * s], bp[2 * s], acc, 0, 0, 0);
    bf16* dst = W3T + (size_t)(hp * 128 + 32 * tj + l31) * D + k0 + 32 * ti + 4 * lh;
    const float* g = gffn + k0 + 32 * ti + 4 * lh;
#pragma unroll
    for (int q = 0; q < 4; ++q) { u32x2 o; o.x = pk2(acc[4 * q] * g[8 * q], acc[4 * q + 1] * g[8 * q + 1]); o.y = pk2(acc[4 * q + 2] * g[8 * q + 2], acc[4 * q + 3] * g[8 * q + 3]);
        *(u32x2*)(dst + 8 * q) = o; }
    __syncthreads();
}
constexpr int RB = 4;
__device__ __forceinline__ void p0_xn(const float* __restrict__ x, bf16* __restrict__ xb, float* __restrict__ rstd1, int gw, int ngw, int lane) {
    for (int r0 = gw * RB; r0 < M; r0 += ngw * RB) {
        float4 v[RB][4];
#pragma unroll
        for (int i = 0; i < RB; ++i)
#pragma unroll
            for (int j = 0; j < 4; ++j) v[i][j] = ((const float4*)(x + (size_t)(r0 + i) * D))[lane + 64 * j];
#pragma unroll
        for (int i = 0; i < RB; ++i) {
            float s = 0.f;
            u32x2* o = (u32x2*)(xb + (size_t)(r0 + i) * D);
#pragma unroll
            for (int j = 0; j < 4; ++j) { s += v[i][j].x * v[i][j].x + v[i][j].y * v[i][j].y + v[i][j].z * v[i][j].z + v[i][j].w * v[i][j].w;
                u32x2 w; w.x = pk2(v[i][j].x, v[i][j].y); w.y = pk2(v[i][j].z, v[i][j].w); o[lane + 64 * j] = w; }
            s = wave_sum(s);
            if (lane == 0) rstd1[r0 + i] = 1.0f / sqrtf(s * (1.0f / D) + EPS);
        }
    }
}
__device__ __forceinline__ void p0_tab4(const float* __restrict__ tab, const float* __restrict__ gain, unsigned char* __restrict__ t4, bf16* __restrict__ scl, int which, int row_lo, int row_hi, int gw, int ngw, int lane) {
    float4 gg[4];
#pragma unroll
    for (int j = 0; j < 4; ++j) gg[j] = gain ? ((const float4*)gain)[lane + 64 * j] : make_float4(1.f, 1.f, 1.f, 1.f);
    for (int r0 = row_lo + gw * RB; r0 < row_hi; r0 += ngw * RB) {
        float4 a[RB][4];
#pragma unroll
        for (int i = 0; i < RB; ++i)
#pragma unroll
            for (int j = 0; j < 4; ++j) a[i][j] = ((const float4*)(tab + (size_t)(r0 + i) * D))[lane + 64 * j];
#pragma unroll
        for (int i = 0; i < RB; ++i) {
            float ss = 0.f;
#pragma unroll
            for (int j = 0; j < 4; ++j) {
                a[i][j].x *= gg[j].x; a[i][j].y *= gg[j].y; a[i][j].z *= gg[j].z; a[i][j].w *= gg[j].w;
                ss += a[i][j].x * a[i][j].x + a[i][j].y * a[i][j].y + a[i][j].z * a[i][j].z + a[i][j].w * a[i][j].w; }
            const float rms = fmaxf(sqrtf(wave_sum(ss) * (1.0f / D)), 1e-30f);
            const float sc = 2.0f / rms;
            u32x2 w;
#pragma unroll
            for (int d = 0; d < 2; ++d) { unsigned t = 0u;
                t = __builtin_amdgcn_cvt_scalef32_pk_fp4_f32(t, a[i][2 * d].x * sc, a[i][2 * d].y * sc, 1.0f, 0);
                t = __builtin_amdgcn_cvt_scalef32_pk_fp4_f32(t, a[i][2 * d].z * sc, a[i][2 * d].w * sc, 1.0f, 1);
                t = __builtin_amdgcn_cvt_scalef32_pk_fp4_f32(t, a[i][2 * d + 1].x * sc, a[i][2 * d + 1].y * sc, 1.0f, 2);
                t = __builtin_amdgcn_cvt_scalef32_pk_fp4_f32(t, a[i][2 * d + 1].z * sc, a[i][2 * d + 1].w * sc, 1.0f, 3);
                w[d] = t; }
            ((u32x2*)(t4 + (size_t)(r0 + i) * 512))[lane] = w;
            if (lane == 0) scl[2 * (r0 + i) + which] = (bf16)f2bf(rms * 0.5f);
        }
    }
}

constexpr int KS_PITCH = 144, VT_PITCH = 400, KS_BYTES = 2 * 192 * KS_PITCH, VT_BYTES = 2 * 64 * VT_PITCH;
__device__ __forceinline__ void p2_attn_unit(const bf16* __restrict__ Q, const bf16* __restrict__ K, const bf16* __restrict__ Vt, const float* __restrict__ sinks, bf16* __restrict__ MIX,
                                             int unit, LAS unsigned char* lds) {
    const int t = threadIdx.x, lane = t & 63, wave = __builtin_amdgcn_readfirstlane(t >> 6), fr = lane & 15, fq = lane >> 4;
    const int bb = unit >> 5, q0 = (unit & 31) * 64;
    const int rowq0 = bb * SEQ + q0, k0pos = q0 - 128;
    LAS unsigned char* Ks = lds; LAS unsigned char* Vts = lds + KS_BYTES; LAS float* ssq = (LAS float*)(lds + KS_BYTES + VT_BYTES);
#pragma unroll
    for (int i = 0; i < 6; ++i) {
        const int idx = t + 512 * i, kj = idx >> 4, c = idx & 15, pos = k0pos + kj;
        u32x4 v = {0u, 0u, 0u, 0u};
        if (pos >= 0) v = *(const u32x4*)(K + (size_t)(bb * SEQ + pos) * 128 + c * 8);
        *(LAS u32x4*)(Ks + ((c >> 3) * 192 + kj) * KS_PITCH + (c & 7) * 16) = v;
    }
#pragma unroll
    for (int i = 0; i < 6; ++i) {
        const int idx = t + 512 * i, r = idx / 24, c = idx - r * 24, pos = k0pos + c * 8;
        u32x4 v = {0u, 0u, 0u, 0u};
        if (pos >= 0) v = *(const u32x4*)(Vt + ((size_t)bb * 128 + r) * SEQ + pos);
        *(LAS u32x4*)(Vts + r * VT_PITCH + c * 16) = v;
    }
    const int hq = wave, kvh = hq >> 2;
    pg8::bf16x8 qf[4][2];
#pragma unroll
    for (int g = 0; g < 4; ++g)
#pragma unroll
        for (int ks = 0; ks < 2; ++ks) qf[g][ks] = *(const pg8::bf16x8*)(Q + (size_t)(rowq0 + 16 * g + fr) * 512 + hq * 64 + ks * 32 + fq * 8);
    const float sink2 = sinks[hq] * 1.44269504089f;
    const int kmin = -k0pos;
    __syncthreads();
    pg8::f32x4 o[4][4];
    LAS unsigned char* Kw = Ks + kvh * 192 * KS_PITCH + fr * KS_PITCH + fq * 16;
    LAS unsigned char* Vw = Vts + (kvh * 64 + fr) * VT_PITCH + fq * 8;
    const int dl = fr - 4 * fq;
#pragma unroll
    for (int gp = 0; gp < 2; ++gp) {
        pg8::f32x4 s[2][10];
        float mx[2] = {sink2, sink2};
#pragma unroll
        for (int jt = 0; jt < 10; ++jt) {
            s[0][jt] = (pg8::f32x4){0.f, 0.f, 0.f, 0.f}; s[1][jt] = (pg8::f32x4){0.f, 0.f, 0.f, 0.f};
#pragma unroll
            for (int ks = 0; ks < 2; ++ks) {
                const pg8::bf16x8 kf = *(const LAS pg8::bf16x8*)(Kw + (2 * gp + jt) * 16 * KS_PITCH + ks * 64);
                if (jt <= 8) s[0][jt] = __builtin_amdgcn_mfma_f32_16x16x32_bf16(kf, qf[2 * gp][ks], s[0][jt], 0, 0, 0);
                if (jt >= 1) s[1][jt] = __builtin_amdgcn_mfma_f32_16x16x32_bf16(kf, qf[2 * gp + 1][ks], s[1][jt], 0, 0, 0);
            }
        }
#pragma unroll
        for (int e = 0; e < 2; ++e)
#pragma unroll
            for (int jt = e; jt <= e + 8; ++jt)
#pragma unroll
                for (int r = 0; r < 4; ++r) {
                    float v = s[e][jt][r];
                    if (jt == e) v = (dl - r < 0) ? v : -1.0e30f;
                    if (jt == e + 8) v = (dl - r >= 0) ? v : -1.0e30f;
                    if (kmin > 0) v = (16 * (2 * gp + jt) + 4 * fq + r >= kmin) ? v : -1.0e30f;
                    s[e][jt][r] = v; mx[e] = fmaxf(mx[e], v);
                }
        float l[2] = {0.f, 0.f};
#pragma unroll
        for (int e = 0; e < 2; ++e) { mx[e] = fmaxf(mx[e], __shfl_xor(mx[e], 16)); }
#pragma unroll
        for (int e = 0; e < 2; ++e) { mx[e] = fmaxf(mx[e], __shfl_xor(mx[e], 32)); }
#pragma unroll
        for (int e = 0; e < 2; ++e)
#pragma unroll
            for (int jt = e; jt <= e + 8; ++jt)
#pragma unroll
                for (int r = 0; r < 4; ++r) { const float p = __builtin_amdgcn_exp2f(s[e][jt][r] - mx[e]); s[e][jt][r] = p; l[e] += p; }
#pragma unroll
        for (int e = 0; e < 2; ++e) l[e] += __shfl_xor(l[e], 16);
#pragma unroll
        for (int e = 0; e < 2; ++e) l[e] += __shfl_xor(l[e], 32);
#pragma unroll
        for (int e = 0; e < 2; ++e)
#pragma unroll
            for (int dt = 0; dt < 4; ++dt) o[2 * gp + e][dt] = (pg8::f32x4){0.f, 0.f, 0.f, 0.f};
#pragma unroll
        for (int sp = 0; sp < 5; ++sp) {
            pg8::bf16x8 pf[2];
#pragma unroll
            for (int e = 0; e < 2; ++e) { u32x4 pw; pw.x = pk2(s[e][2 * sp][0], s[e][2 * sp][1]); pw.y = pk2(s[e][2 * sp][2], s[e][2 * sp][3]);
                pw.z = pk2(s[e][2 * sp + 1][0], s[e][2 * sp + 1][1]); pw.w = pk2(s[e][2 * sp + 1][2], s[e][2 * sp + 1][3]); pf[e] = __builtin_bit_cast(pg8::bf16x8, pw); }
#pragma unroll
            for (int dt = 0; dt < 4; ++dt) {
                const LAS unsigned char* vp = Vw + dt * 16 * VT_PITCH + (gp + sp) * 64;
                u32x4 vw; const u32x2 lo = *(const LAS u32x2*)vp, hi = *(const LAS u32x2*)(vp + 32); vw.x = lo.x; vw.y = lo.y; vw.z = hi.x; vw.w = hi.y;
                const pg8::bf16x8 vf = __builtin_bit_cast(pg8::bf16x8, vw);
                o[2 * gp][dt] = __builtin_amdgcn_mfma_f32_16x16x32_bf16(vf, pf[0], o[2 * gp][dt], 0, 0, 0);
                o[2 * gp + 1][dt] = __builtin_amdgcn_mfma_f32_16x16x32_bf16(vf, pf[1], o[2 * gp + 1][dt], 0, 0, 0);
            }
        }
#pragma unroll
        for (int e = 0; e < 2; ++e) {
            const int g = 2 * gp + e;
            const float il = __builtin_amdgcn_rcpf(l[e] + __builtin_amdgcn_exp2f(sink2 - mx[e]));
            float sq = 0.f;
#pragma unroll
            for (int dt = 0; dt < 4; ++dt) { o[g][dt] = o[g][dt] * il; sq += o[g][dt][0] * o[g][dt][0] + o[g][dt][1] * o[g][dt][1] + o[g][dt][2] * o[g][dt][2] + o[g][dt][3] * o[g][dt][3]; }
            sq += __shfl_xor(sq, 16); sq += __shfl_xor(sq, 32);
            if (fq == 0) ssq[wave * 64 + 16 * g + fr] = sq;
        }
    }
    __syncthreads();
#pragma unroll
    for (int g = 0; g < 4; ++g) {
        float tot = 0.f;
#pragma unroll
        for (int w = 0; w < 8; ++w) tot += ssq[w * 64 + 16 * g + fr];
        const float rs = 1.0f / sqrtf(tot * (1.0f / 512.0f) + EPS);
#pragma unroll
        for (int dt = 0; dt < 4; ++dt) { const pg8::f32x4 v = o[g][dt] * rs; u32x2 w2; w2.x = pk2(v[0], v[1]); w2.y = pk2(v[2], v[3]);
            *(u32x2*)(MIX + (size_t)(rowq0 + 16 * g + fr) * D + hq * 64 + dt * 16 + fq * 4) = w2; }
    }
    __syncthreads();
}

constexpr int YP = 520;
__device__ __forceinline__ void p2_conv_unit(const bf16* __restrict__ U, const float (&w)[CK][2], const float b0, const float b1, const float* __restrict__ lng, const float* __restrict__ lnb,
                                             bf16* __restrict__ MIX, int unit, float* ybuf) {
    const int t = threadIdx.x, lane = t & 63, wave = __builtin_amdgcn_readfirstlane(t >> 6), cp = t & 255, hf = t >> 8;
    const int bb = unit >> 6, t0 = (unit & 63) * 32;
    const int tb = t0 + 16 * hf;
    float acc[16][2];
#pragma unroll
    for (int o = 0; o < 16; ++o) { acc[o][0] = b0; acc[o][1] = b1; }
    const bf16* up = U + (size_t)bb * SEQ * 512 + 2 * cp;
#pragma unroll
    for (int rr = 0; rr < 46; ++rr) {
        const int tp = tb - 30 + rr;
        unsigned uw = 0u;
        if (tp >= 0) uw = *(const unsigned*)(up + (size_t)tp * 512);
        const float u0 = bflo(uw), u1 = bfhi(uw);
#pragma unroll
        for (int o = 0; o < 16; ++o) { const int j = rr - o; if (j >= 0 && j < CK) { acc[o][0] += w[j][0] * u0; acc[o][1] += w[j][1] * u1; } }
    }
#pragma unroll
    for (int o = 0; o < 16; ++o) *(f32x2*)(ybuf + (16 * hf + o) * YP + 2 * cp) = (f32x2){acc[o][0], acc[o][1]};
    __syncthreads();
    const int c8 = lane * 8;
    const f32x4 g0 = *(const f32x4*)(lng + c8), g1 = *(const f32x4*)(lng + c8 + 4), e0 = *(const f32x4*)(lnb + c8), e1 = *(const f32x4*)(lnb + c8 + 4);
    const float gg[8] = {g0[0], g0[1], g0[2], g0[3], g1[0], g1[1], g1[2], g1[3]}, ee[8] = {e0[0], e0[1], e0[2], e0[3], e1[0], e1[1], e1[2], e1[3]};
    float y[4][8], red[4];
#pragma unroll
    for (int i = 0; i < 4; ++i) {
        const f32x4 ya = *(const f32x4*)(ybuf + (wave * 4 + i) * YP + c8), yb = *(const f32x4*)(ybuf + (wave * 4 + i) * YP + c8 + 4);
        y[i][0] = ya[0]; y[i][1] = ya[1]; y[i][2] = ya[2]; y[i][3] = ya[3]; y[i][4] = yb[0]; y[i][5] = yb[1]; y[i][6] = yb[2]; y[i][7] = yb[3];
        red[i] = 0.f;
#pragma unroll
        for (int k = 0; k < 8; ++k) red[i] += y[i][k];
    }
    wave_sum4(red);
#pragma unroll
    for (int i = 0; i < 4; ++i) { const float mu = red[i] * (1.0f / CC); red[i] = 0.f;
#pragma unroll
        for (int k = 0; k < 8; ++k) { y[i][k] -= mu; red[i] += y[i][k] * y[i][k]; } }
    wave_sum4(red);
#pragma unroll
    for (int i = 0; i < 4; ++i) { const float rstd = 1.0f / sqrtf(red[i] * (1.0f / CC) + EPS); red[i] = 0.f;
#pragma unroll
        for (int k = 0; k < 8; ++k) { const float z = y[i][k] * rstd * gg[k] + ee[k]; const float a = z * __builtin_amdgcn_rcpf(1.0f + __builtin_amdgcn_exp2f(z * -1.44269504089f)); y[i][k] = a; red[i] += a * a; } }
    wave_sum4(red);
#pragma unroll
    for (int i = 0; i < 4; ++i) { const float rs = 1.0f / sqrtf(red[i] * (1.0f / CC) + EPS);
        u32x4 ow; ow.x = pk2(y[i][0] * rs, y[i][1] * rs); ow.y = pk2(y[i][2] * rs, y[i][3] * rs); ow.z = pk2(y[i][4] * rs, y[i][5] * rs); ow.w = pk2(y[i][6] * rs, y[i][7] * rs);
        *(u32x4*)(MIX + (size_t)(bb * SEQ + t0 + wave * 4 + i) * D + 512 + c8) = ow; }
    __syncthreads();
}

__device__ __forceinline__ void ins16(float (&t)[16], const float x) {
#pragma unroll
    for (int i = 15; i >= 1; --i) t[i] = __builtin_amdgcn_fmed3f(t[i - 1], t[i], x);
    t[0] = fmaxf(t[0], x);
}
__device__ __forceinline__ float packf(float v, unsigned tag, unsigned keepmask) { return __builtin_bit_cast(float, (__builtin_bit_cast(unsigned, v) & keepmask) | tag); }
__device__ __forceinline__ void p4_topk_lists(const float* __restrict__ slot, float* lst) {
    const int t = threadIdx.x, row = t & 255, p = t >> 8;
    float L[16];
#pragma unroll
    for (int i = 0; i < 16; ++i) L[i] = -3.0e38f;
    const f32x4* sp = (const f32x4*)slot + (size_t)p * 32 * 256 + row;
#pragma unroll 8
    for (int c4 = 0; c4 < 32; ++c4) {
        const f32x4 s = sp[c4 * 256];
#pragma unroll
        for (int j = 0; j < 4; ++j) ins16(L, packf(s[j], (unsigned)(c4 * 4 + j), 0xFFFFFF80u));
    }
#pragma unroll
    for (int j = 0; j < 16; ++j) lst[(p * 16 + j) * 256 + row] = L[j];
}
__device__ __forceinline__ void p4_topk_pairs(const float* lst, int row, const unsigned* __restrict__ scl, unsigned (&res)[48]) {
    float Av[16], Bv[16], best[16];
#pragma unroll
    for (int j = 0; j < 16; ++j) { Av[j] = packf(lst[j * 256 + row], 0u, 0xFFFFFF80u); Bv[j] = packf(lst[(16 + j) * 256 + row], 0u, 0xFFFFFF80u); best[j] = -3.0e38f; }
#pragma unroll
    for (int i = 0; i < 16; ++i)
#pragma unroll
        for (int j = 0; j < 16 / (i + 1); ++j) ins16(best, packf(Av[i] + Bv[j], (unsigned)(i * 16 + j), 0xFFFFFF00u));
#pragma unroll
    for (int r = 0; r < 16; ++r) {
        const unsigned code = __builtin_bit_cast(unsigned, best[r]) & 255u;
        const unsigned ka = __builtin_bit_cast(unsigned, lst[(code >> 4) * 256 + row]) & 127u, kb = __builtin_bit_cast(unsigned, lst[(16 + (code & 15u)) * 256 + row]) & 127u;
        res[r] = (int)(ka * NK + kb); res[17 + 2 * r] = scl[res[r]];
        res[16 + 2 * r] = __builtin_bit_cast(unsigned, best[r]) & 0xFFFFFF00u;
    }
}
constexpr int STG_PITCH = 52;
__device__ __forceinline__ void p4_stage(const unsigned (&res)[48], int row, unsigned* stg) {
#pragma unroll
    for (int k = 0; k < 12; ++k) *(u32x4*)(stg + row * STG_PITCH + 4 * k) = (u32x4){res[4 * k], res[4 * k + 1], res[4 * k + 2], res[4 * k + 3]};
}
__device__ __forceinline__ void p4_store(const unsigned* stg, int t, int row_base, int head, int* __restrict__ ids, f32x2* __restrict__ meta) {
    const int w = t >> 6, lane = t & 63;
#pragma unroll
    for (int i = 0; i < 8; ++i) { const int row = 64 * w + 8 * i + (lane >> 3), ch = lane & 7;
        *(u32x4*)((unsigned*)(meta + (size_t)(row_base + row) * 128 + head * 16) + 4 * ch) = *(const u32x4*)(stg + row * STG_PITCH + 16 + 4 * ch); }
#pragma unroll
    for (int i = 0; i < 4; ++i) { const int row = 64 * w + 16 * i + (lane >> 2), ch = lane & 3;
        *(u32x4*)((unsigned*)(ids + (size_t)(row_base + row) * 128 + head * 16) + 4 * ch) = *(const u32x4*)(stg + row * STG_PITCH + 4 * ch); }
}

__device__ __forceinline__ float gelu_exact(float v) {
    const float av = fabsf(v), t = __builtin_amdgcn_rcpf(av * 0.2316418882f + 1.0f);
    float q = t * 0.5307027145f + (-0.7265760135f); q = q * t + 0.7107068705f; q = q * t + (-0.142248368f); q = q * t + 0.127414796f; q = q * t;
    const float e = __builtin_amdgcn_exp2f(v * v * (-0.72134752044f));
    const float m = v * (q * e);
    return v < 0.f ? m : v - m;
}
constexpr int P5_WAVE_LDS = 3 * 128 * 12;
struct P5Raw { int idA, idB; f32x2 mA, mB; u32x2 hx[4]; };
__device__ __forceinline__ void p5_load(P5Raw& q, const bf16* __restrict__ h, const int* __restrict__ ids, const f32x2* __restrict__ meta, int r, int lane) {
    q.idA = ids[(size_t)r * 128 + lane]; q.idB = ids[(size_t)r * 128 + 64 + lane];
    q.mA = meta[(size_t)r * 128 + lane]; q.mB = meta[(size_t)r * 128 + 64 + lane];
    const u32x2* hr = (const u32x2*)(h + (size_t)r * D);
#pragma unroll
    for (int j = 0; j < 4; ++j) q.hx[j] = hr[lane + 64 * j];
}
__device__ __forceinline__ void p5_rank8(int kA, int kB, int& posA, int& posB) {
    int base = 0; posA = 0; posB = 0;
#pragma unroll
    for (int p = 0; p < 8; ++p) {
        const unsigned long long ba = __ballot(kA == p), bb = __ballot(kB == p);
        const int ra = __builtin_amdgcn_mbcnt_hi((unsigned)(ba >> 32), __builtin_amdgcn_mbcnt_lo((unsigned)ba, 0u));
        const int rb = __builtin_amdgcn_mbcnt_hi((unsigned)(bb >> 32), __builtin_amdgcn_mbcnt_lo((unsigned)bb, 0u));
        const int ca = __popcll(ba), cb = __popcll(bb);
        posA = (kA == p) ? base + ra : posA;
        posB = (kB == p) ? base + ca + rb : posB;
        base += ca + cb;
    }
}
constexpr int P5_LOW = 8;
__device__ __forceinline__ float p5_sort(const P5Raw& q, LAS unsigned char* wl, int buf, int lane) {
    float ssq = 0.f;
#pragma unroll
    for (int j = 0; j < 4; ++j) { const float a = bflo(q.hx[j].x), b = bfhi(q.hx[j].x), c = bflo(q.hx[j].y), d = bfhi(q.hx[j].y); ssq += a * a + b * b + c * c + d * d; }
    const float rs = 1.0f / sqrtf(wave_sum(ssq) * (1.0f / D) + EPS);
    const float ta = q.mA.x * rs, tb = q.mB.x * rs;
    float ma = ta, mb = tb;
#pragma unroll
    for (int o = 1; o < 16; o <<= 1) { ma = fmaxf(ma, __shfl_xor(ma, o)); mb = fmaxf(mb, __shfl_xor(mb, o)); }
    const float ea = __expf(ta - ma), eb = __expf(tb - mb);
    float sa = ea, sb = eb;
#pragma unroll
    for (int o = 1; o < 16; o <<= 1) { sa += __shfl_xor(sa, o); sb += __shfl_xor(sb, o); }
    const float ga = ea / sa, gb = eb / sb;
    LAS unsigned* t_so = (LAS unsigned*)(wl + 2 * 1536); LAS f32x2* t_sm = (LAS f32x2*)(wl + 2 * 1536 + 512);
    LAS unsigned* so = (LAS unsigned*)(wl + buf * 1536); LAS f32x2* sm = (LAS f32x2*)(wl + buf * 1536 + 512);
    int posA, posB;
    p5_rank8((q.idA >> P5_LOW) & 7, (q.idB >> P5_LOW) & 7, posA, posB);
    t_so[posA] = (unsigned)q.idA; t_so[posB] = (unsigned)q.idB;
    t_sm[posA] = (f32x2){ga, q.mA.y}; t_sm[posB] = (f32x2){gb, q.mB.y};
    const unsigned i2A = t_so[lane], i2B = t_so[lane + 64];
    const f32x2 m2A = t_sm[lane], m2B = t_sm[lane + 64];
    p5_rank8((int)(i2A >> (P5_LOW + 3)), (int)(i2B >> (P5_LOW + 3)), posA, posB);
    so[posA] = i2A * 512u; so[posB] = i2B * 512u;
    sm[posA] = m2A; sm[posB] = m2B;
    return rs;
}
typedef _Float16 f16x2 __attribute__((ext_vector_type(2)));
__device__ __forceinline__ void axpy16_fp4_h(const u32x2 v, const f16x2 w2, f16x2 (&acc)[8]) {
#pragma unroll
    for (int d = 0; d < 2; ++d) {
        acc[4 * d + 0] = __builtin_elementwise_fma(__builtin_bit_cast(f16x2, __builtin_amdgcn_cvt_scalef32_pk_f16_fp4(v[d], 1.0f, 0)), w2, acc[4 * d + 0]);
        acc[4 * d + 1] = __builtin_elementwise_fma(__builtin_bit_cast(f16x2, __builtin_amdgcn_cvt_scalef32_pk_f16_fp4(v[d], 1.0f, 1)), w2, acc[4 * d + 1]);
        acc[4 * d + 2] = __builtin_elementwise_fma(__builtin_bit_cast(f16x2, __builtin_amdgcn_cvt_scalef32_pk_f16_fp4(v[d], 1.0f, 2)), w2, acc[4 * d + 2]);
        acc[4 * d + 3] = __builtin_elementwise_fma(__builtin_bit_cast(f16x2, __builtin_amdgcn_cvt_scalef32_pk_f16_fp4(v[d], 1.0f, 3)), w2, acc[4 * d + 3]);
    }
}
typedef int i32x8 __attribute__((ext_vector_type(8)));
constexpr float P5_HS = 8.0f;
constexpr int P5_BIMG = 3 * 1536, P5_BLO = 1024 + 16, P5_BSZ = 2048 + 64;
constexpr int P5_WAVE_LDS2 = P5_BIMG + 2 * P5_BSZ;
__device__ __forceinline__ void p5_bimage(const u32x2 (&hx)[4], LAS unsigned char* img, int lane) {
    u32x4 bh, bl;
#pragma unroll
    for (int t = 0; t < 4; ++t) {
        const float a0 = bflo(hx[t].x) * P5_HS, a1 = bfhi(hx[t].x) * P5_HS, a2 = bflo(hx[t].y) * P5_HS, a3 = bfhi(hx[t].y) * P5_HS;
        int wv = 0;
        wv = __builtin_amdgcn_cvt_pk_fp8_f32(__builtin_amdgcn_fmed3f(a0, -440.f, 440.f), __builtin_amdgcn_fmed3f(a1, -440.f, 440.f), wv, false);
        wv = __builtin_amdgcn_cvt_pk_fp8_f32(__builtin_amdgcn_fmed3f(a2, -440.f, 440.f), __builtin_amdgcn_fmed3f(a3, -440.f, 440.f), wv, true);
        const float r0 = a0 - __builtin_amdgcn_cvt_f32_fp8(wv, 0), r1 = a1 - __builtin_amdgcn_cvt_f32_fp8(wv, 1), r2 = a2 - __builtin_amdgcn_cvt_f32_fp8(wv, 2), r3 = a3 - __builtin_amdgcn_cvt_f32_fp8(wv, 3);
        int wl2 = 0;
        wl2 = __builtin_amdgcn_cvt_pk_fp8_f32(__builtin_amdgcn_fmed3f(r0, -440.f, 440.f), __builtin_amdgcn_fmed3f(r1, -440.f, 440.f), wl2, false);
        wl2 = __builtin_amdgcn_cvt_pk_fp8_f32(__builtin_amdgcn_fmed3f(r2, -440.f, 440.f), __builtin_amdgcn_fmed3f(r3, -440.f, 440.f), wl2, true);
        bh[t] = (unsigned)wv; bl[t] = (unsigned)wl2;
    }
    *(LAS u32x4*)(img + lane * 16) = bh; *(LAS u32x4*)(img + P5_BLO + lane * 16) = bl;
}
__device__ __forceinline__ f32x4 p5_mfma(const u32x4 a, const u32x4 b0, const u32x4 b1, const f32x4 c) {
    const i32x8 bv = {(int)b0.x, (int)b0.y, (int)b0.z, (int)b0.w, (int)b1.x, (int)b1.y, (int)b1.z, (int)b1.w};
    const i32x8 av = {(int)a.x, (int)a.y, (int)a.z, (int)a.w, 0, 0, 0, 0};
    return __builtin_amdgcn_mfma_scale_f32_16x16x128_f8f6f4(av, bv, c, 4  , 0  , 0, 0x7F7F7F7F, 0, 0x7F7F7F7F);
}
__device__ __forceinline__ float p5_weight(const f32x4 dv, const f32x2 mt, const float rs, int lane) {
    float d4[4];
#pragma unroll
    for (int i = 0; i < 4; ++i) { const float di = dv[i]; d4[i] = di + __builtin_bit_cast(float, __builtin_amdgcn_mov_dpp(__builtin_bit_cast(int, di), 0xB1, 0xF, 0xF, true)); }
    const int l3 = lane & 3;
    float pd = d4[0]; pd = (l3 == 1) ? d4[1] : pd; pd = (l3 == 2) ? d4[2] : pd; pd = (l3 == 3) ? d4[3] : pd;
    const float g1 = mt.x, sc2 = mt.y;
    const unsigned scb = __builtin_bit_cast(unsigned, sc2);
    return g1 * bfhi(scb) * gelu_exact(pd * rs * bflo(scb));
}
__device__ __forceinline__ void p5_peer(const bf16* __restrict__ h, const int* __restrict__ ids, const f32x2* __restrict__ meta, const unsigned char* __restrict__ u4, const unsigned char* __restrict__ v4,
                                        const float* __restrict__ gfin, float* __restrict__ out, int gw, int ngw, int rend, int lane, LAS unsigned char* wl) {
    const __amdgpu_buffer_rsrc_t ru = __builtin_amdgcn_make_buffer_rsrc((void*)u4, (short)0, NE * 512, 0x00020000);
    const __amdgpu_buffer_rsrc_t rv = __builtin_amdgcn_make_buffer_rsrc((void*)v4, (short)0, NE * 512, 0x00020000);
    const int voff = lane * 8, uoff = 16 * (lane >> 4);
    const int boff = ((lane & 1) ? P5_BLO : 0) + 16 * (lane >> 4);
    const int mtoff = 4 * (lane >> 4) + (lane & 3);
    u32x4 A[8]; u32x2 V[16], hxn[4];
    int nid[16];
    unsigned xu;
    float rsn, w;
    {
        P5Raw q; p5_load(q, h, ids, meta, gw, lane);
        rsn = p5_sort(q, wl, 0, lane);
#pragma unroll
        for (int j = 0; j < 4; ++j) hxn[j] = q.hx[j];
        p5_bimage(hxn, wl + P5_BIMG, lane);
        const unsigned x0 = ((LAS unsigned*)wl)[lane & 15], x1 = ((LAS unsigned*)wl)[16 + (lane & 15)];
        xu = ((LAS unsigned*)wl)[32 + (lane & 15)];
#pragma unroll
        for (int c = 0; c < 8; ++c) A[c] = __builtin_amdgcn_raw_buffer_load_b128(ru, (int)x0 + uoff + 64 * c, 0, 0);
#pragma unroll
        for (int j = 0; j < 16; ++j) V[j] = __builtin_amdgcn_raw_buffer_load_b64(rv, voff, __builtin_amdgcn_readlane((int)x0, j), 0);
        f32x4 dv = {0.f, 0.f, 0.f, 0.f};
        const LAS unsigned char* bs = wl + P5_BIMG + boff;
#pragma unroll
        for (int c = 0; c < 8; ++c) {
            dv = p5_mfma(A[c], *(const LAS u32x4*)(bs + 128 * c), *(const LAS u32x4*)(bs + 128 * c + 64), dv);
            A[c] = __builtin_amdgcn_raw_buffer_load_b128(ru, (int)x1 + uoff + 64 * c, 0, 0);
        }
        w = p5_weight(dv, ((LAS f32x2*)(wl + 512))[mtoff], rsn * (1.0f / P5_HS), lane);
#pragma unroll
        for (int j = 0; j < 16; ++j) nid[j] = __builtin_amdgcn_readlane((int)x1, j);
    }
    int buf = 0;
    for (int r = gw; r < rend; r += ngw, buf ^= 1) {
        const int rnext = (r + ngw < rend) ? r + ngw : r;
        const bool last = (r + ngw >= rend);
        f32x2 acc[8]; u32x2 hcur[4];
#pragma unroll
        for (int j = 0; j < 4; ++j) hcur[j] = hxn[j];
#pragma unroll
        for (int j = 0; j < 8; ++j) acc[j] = (f32x2){0.f, 0.f};
        float rs1 = rsn * (1.0f / P5_HS);
        auto batch = [&](const int b) {
            const int e3 = (b + 3) * 16 + (lane & 15);
            unsigned x3 = ((LAS unsigned*)(wl + ((e3 >> 7) ^ buf) * 1536))[e3 & 127];
            if (last && b + 3 >= 8) x3 = 0x7F000000u;
            const int e1 = (b + 1) * 16 + mtoff;
            const f32x2 mt = ((LAS f32x2*)(wl + ((e1 >> 7) ^ buf) * 1536 + 512))[e1 & 127];
            const LAS unsigned char* bs = wl + P5_BIMG + ((((b + 1) >> 3) ^ buf) & 1) * P5_BSZ + boff;
            const int vu2 = (int)xu + uoff;
            const f16x2 wh = {(_Float16)w, (_Float16)w};
            f16x2 a16[8];
#pragma unroll
            for (int j = 0; j < 8; ++j) a16[j] = (f16x2){(_Float16)0.f, (_Float16)0.f};
            f32x4 dv = {0.f, 0.f, 0.f, 0.f};
            u32x4 B0[2], B1[2];
            B0[0] = *(const LAS u32x4*)bs; B1[0] = *(const LAS u32x4*)(bs + 64);
#pragma unroll
            for (int j = 0; j < 16; ++j) {
                if ((j & 1) == 0) {
                    const int c = j >> 1;
                    if (c + 1 < 8) { B0[(c + 1) & 1] = *(const LAS u32x4*)(bs + 128 * (c + 1)); B1[(c + 1) & 1] = *(const LAS u32x4*)(bs + 128 * (c + 1) + 64); }
                    dv = p5_mfma(A[c], B0[c & 1], B1[c & 1], dv);
                    A[c] = __builtin_amdgcn_raw_buffer_load_b128(ru, vu2 + 64 * c, 0, 0);
                    __builtin_amdgcn_sched_barrier(0);
                }
                const f16x2 wj = __builtin_bit_cast(f16x2, __builtin_amdgcn_readlane(__builtin_bit_cast(int, wh), 16 * (j >> 2) + (j & 3)));
                axpy16_fp4_h(V[j], wj, a16);
                V[j] = __builtin_amdgcn_raw_buffer_load_b64(rv, voff, nid[j], 0);
                __builtin_amdgcn_sched_barrier(0);
            }
#pragma unroll
            for (int j = 0; j < 8; ++j) { const f16x2 t = a16[j]; acc[j] += (f32x2){(float)t.x, (float)t.y}; }
            w = p5_weight(dv, mt, rs1, lane);
#pragma unroll
            for (int j = 0; j < 16; ++j) nid[j] = __builtin_amdgcn_readlane((int)xu, j);
            xu = x3;
        };
        P5Raw q; p5_load(q, h, ids, meta, rnext, lane);
        __builtin_amdgcn_sched_barrier(0);
        batch(0);
        rsn = p5_sort(q, wl, buf ^ 1, lane);
#pragma unroll
        for (int j = 0; j < 4; ++j) hxn[j] = q.hx[j];
        p5_bimage(hxn, wl + P5_BIMG + (buf ^ 1) * P5_BSZ, lane);
#pragma unroll 1
        for (int b = 1; b < 7; ++b) batch(b);
        rs1 = rsn * (1.0f / P5_HS);
        batch(7);
        float s = 0.f;
#pragma unroll
        for (int j = 0; j < 4; ++j) { acc[2 * j] += (f32x2){bflo(hcur[j].x), bfhi(hcur[j].x)}; acc[2 * j + 1] += (f32x2){bflo(hcur[j].y), bfhi(hcur[j].y)}; }
#pragma unroll
        for (int j = 0; j < 8; ++j) s += acc[j].x * acc[j].x + acc[j].y * acc[j].y;
        s = wave_sum(s);
        const float rf = 1.0f / sqrtf(s * (1.0f / D) + EPS);
        float4* orow = (float4*)(out + (size_t)r * D);
#pragma unroll
        for (int j = 0; j < 4; ++j) { const float4 gg = ((const float4*)gfin)[lane + 64 * j];
            orow[lane + 64 * j] = make_float4(acc[2 * j].x * rf * gg.x, acc[2 * j].y * rf * gg.y, acc[2 * j + 1].x * rf * gg.z, acc[2 * j + 1].y * rf * gg.w); }
    }
}

#define XB_TMO      128
#define XB_XCNT(j)  (256  + 64 * (j))
#define XB_XSUB(j)  (1280 + 64 * (j))
#define XB_XGEN(j)  (2304 + 64 * (j))
#define XB_TOP      3328
#define XB_TOPGEN   3392
#define XCD_BAR_WORDS 3456
#define XB_LSUB(j)  (3456 + 64 * (j))
#define XB_LGEN(j)  (4480 + 64 * (j))
#define XB_SPIN_CAP (1u << 18)

__device__ __forceinline__ unsigned xb_ld(unsigned* p)              { return __hip_atomic_load(p, __ATOMIC_RELAXED, __HIP_MEMORY_SCOPE_AGENT); }
__device__ __forceinline__ unsigned xb_add(unsigned* p, unsigned v) { return __hip_atomic_fetch_add(p, v, __ATOMIC_RELAXED, __HIP_MEMORY_SCOPE_AGENT); }
__device__ __forceinline__ unsigned xb_xcc_id() { return (unsigned)__builtin_amdgcn_s_getreg((3 << 11) | 20) & 0xFu; }
#define XB_SPIN(cond, bar) do { unsigned _sp = 0; while (cond) { __builtin_amdgcn_s_sleep(1); \
    if ((++_sp & 255u) == 0u) { if (xb_ld(&(bar)[XB_TMO])) break; if (_sp > XB_SPIN_CAP) { atomicAdd(&(bar)[XB_TMO], 1u); break; } } } } while (0)

struct XcdBarrier {
    unsigned* bar; unsigned x;
    volatile LAS unsigned* st;
};

__device__ __forceinline__ XcdBarrier xcd_barrier_post(unsigned* bar, volatile LAS unsigned* st) {
    XcdBarrier b; b.bar = bar; b.x = xb_xcc_id(); b.st = st;
    if (threadIdx.x == 0) st[3] = xb_add(&bar[XB_XCNT(b.x)], 1u) + 1u;
    return b;
}
__device__ __forceinline__ void xcd_barrier_complete(unsigned* bar, unsigned x, unsigned& nloc, unsigned& nx, unsigned& uni) {
    const unsigned G = gridDim.x * gridDim.y * gridDim.z;
    unsigned sum, cnt, mine, sp = 0u;
    for (;;) {
        sum = 0u; cnt = 0u; mine = 0u; uni = 1u;
#pragma unroll
        for (unsigned j = 0; j < 16; ++j) { const unsigned c = xb_ld(&bar[XB_XCNT(j)]); sum += c; cnt += (c > 0u) ? 1u : 0u; mine = (j == x) ? c : mine;
            uni = (j < 8u ? c == G / 8u : c == 0u) ? uni : 0u; }
        if (sum == G) break;
        __builtin_amdgcn_s_sleep(1);
        if ((++sp & 255u) == 0u) { if (xb_ld(&bar[XB_TMO])) break; if (sp > XB_SPIN_CAP) { atomicAdd(&bar[XB_TMO], 1u); break; } }
    }
    nloc = mine > 0u ? mine : 1u; nx = cnt > 0u ? cnt : 1u;
}

__device__ __forceinline__ bool G8ok() { const unsigned G = gridDim.x * gridDim.y * gridDim.z; return (G % 8u) == 0u; }
__device__ __forceinline__ void xcc_local_barrier(const XcdBarrier& b) {
    asm volatile("s_waitcnt vmcnt(0)" ::: "memory");
    __syncthreads();
    if (threadIdx.x == 0) {
        unsigned* bar = b.bar;
        const unsigned nloc = b.st[0];
        const unsigned old = xb_add(&bar[XB_LSUB(b.x)], 1u);
        const unsigned gen = old / nloc;
        __builtin_amdgcn_fence(__ATOMIC_ACQUIRE, "agent");
        if (old + 1u == (gen + 1u) * nloc) xb_add(&bar[XB_LGEN(b.x)], 1u);
        else XB_SPIN(xb_ld(&bar[XB_LGEN(b.x)]) == gen, bar);
        asm volatile("s_waitcnt vmcnt(0)" ::: "memory");
    }
    __syncthreads();
}

__device__ __forceinline__ void xcd_barrier(const XcdBarrier& b) {
    asm volatile("s_waitcnt vmcnt(0)" ::: "memory");
    __syncthreads();
    if (threadIdx.x == 0) {
        unsigned* bar = b.bar;
        __builtin_amdgcn_s_waitcnt(0);
        unsigned nloc = b.st[0], nx = b.st[1];
        if (nloc == 0u) { unsigned uni; xcd_barrier_complete(bar, b.x, nloc, nx, uni); b.st[0] = nloc; b.st[1] = nx; b.st[2] = (uni && G8ok()) ? 1u : 0u; }
        const unsigned old = xb_add(&bar[XB_XSUB(b.x)], 1u);
        const unsigned gen = old / nloc;
        if (old + 1u == (gen + 1u) * nloc) {
            __builtin_amdgcn_fence(__ATOMIC_RELEASE, "agent");
            asm volatile("s_waitcnt vmcnt(0)" ::: "memory");
            const unsigned og = xb_add(&bar[XB_TOP], 1u);
            const unsigned tg = og / nx;
            __builtin_amdgcn_fence(__ATOMIC_ACQUIRE, "agent");
            if (og + 1u == (tg + 1u) * nx) xb_add(&bar[XB_TOPGEN], 1u);
            else XB_SPIN(xb_ld(&bar[XB_TOPGEN]) == tg, bar);
            xb_add(&bar[XB_XGEN(b.x)], 1u);
            asm volatile("s_waitcnt vmcnt(0)" ::: "memory");
        } else {
            __builtin_amdgcn_fence(__ATOMIC_ACQUIRE, "agent");
            XB_SPIN(xb_ld(&bar[XB_XGEN(b.x)]) == gen, bar);
            asm volatile("s_waitcnt vmcnt(0)" ::: "memory");
        }
    }
    __syncthreads();
}

struct Params {
    const float* in[17];
    float* out;
    unsigned char* ws;
};

__global__ void __launch_bounds__(NT, 2) fwd_megakernel(Params prm) {
    extern __shared__ __attribute__((aligned(16))) unsigned char smem[];
    const float* x = prm.in[0];
    const float* norm_mix_g = prm.in[1];
    const float* w_in = prm.in[2];
    const float* conv_w = prm.in[3];
    const float* conv_b = prm.in[4];
    const float* conv_ln_g = prm.in[5];
    const float* conv_ln_b = prm.in[6];
    const float* attn_sinks = prm.in[7];
    const float* attn_out_g = prm.in[8];
    const float* conv_out_g = prm.in[9];
    const float* w_out = prm.in[10];
    const float* norm_ffn_g = prm.in[11];
    const float* peer_w_q = prm.in[12];
    const float* peer_sub_keys = prm.in[13];
    const float* peer_u = prm.in[14];
    const float* peer_v = prm.in[15];
    const float* final_norm_g = prm.in[16];
    unsigned char* ws = prm.ws;
    bf16* W1T = (bf16*)(ws + WS_W1T); bf16* W2T = (bf16*)(ws + WS_W2T); bf16* W3T = (bf16*)(ws + WS_W3T);
    float* ctab = (float*)(ws + WS_ROPE); float* stab = ctab + SEQ * 32;
    bf16* scl = (bf16*)(ws + WS_SCL);
    unsigned char* u8 = ws + WS_U8; unsigned char* v8 = ws + WS_V8;
    bf16* XN = (bf16*)(ws + WS_XN); bf16* MIX = (bf16*)(ws + WS_MIX); float* rstd1 = (float*)(ws + WS_RSTD1);
    bf16* Qb = (bf16*)(ws + WS_Q); bf16* Kb = (bf16*)(ws + WS_K); bf16* Vb = (bf16*)(ws + WS_V); bf16* UB = (bf16*)(ws + WS_UB);
    bf16* HB = (bf16*)(ws + WS_HB);
    int* ids = (int*)(ws + WS_IDS); f32x2* meta = (f32x2*)(ws + WS_META);
    float* slot = (float*)(ws + WS_SC) + (size_t)blockIdx.x * (2 * 32 * 256 * 4);

    const int tid = threadIdx.x, lane = tid & 63, wave = __builtin_amdgcn_readfirstlane(tid >> 6);
    const int G = gridDim.x, gw = blockIdx.x * NWAVES + wave, ngw = G * NWAVES, gtid = blockIdx.x * NT + tid, gthreads = G * NT;
    LAS unsigned char* lds = (LAS unsigned char*)smem;
    volatile LAS unsigned* MISC = (volatile LAS unsigned*)(lds + MISC_OFF);
    if (tid < 16) MISC[tid] = 0u;
    __syncthreads();
    const XcdBarrier bar = xcd_barrier_post((unsigned*)(ws + WS_CTL), MISC);

    for (int rep = 0; rep < REP0; ++rep) {
    if ((blockIdx.x & 1) == 0) for (int item = blockIdx.x; item < 256; item += G) p0_fold_item(peer_w_q, peer_sub_keys, norm_ffn_g, W3T, item, (float*)smem);
    p0_transpose<0>(w_in, INW, INW, W1T, norm_mix_g, nullptr, gtid, gthreads);
    p0_transpose<1>(w_out, D, D, W2T, attn_out_g, conv_out_g, gtid, gthreads);
    for (int i = gtid; i < SEQ * 32; i += gthreads) { const int pos = i >> 5, ii = i & 31;
        const float ang = (float)pos * powf(10000.0f, -(float)ii / 32.0f); ctab[i] = cosf(ang); stab[i] = sinf(ang); }
    p0_xn(x, XN, rstd1, gw, ngw, lane);
    const int tab_p1 = (G == 256) ? TAB_P1 : 0;
    p0_tab4(peer_u, norm_ffn_g, u8, scl, 0, tab_p1, NE, gw, ngw, lane);
    p0_tab4(peer_v, nullptr, v8, scl, 1, tab_p1, NE, gw, ngw, lane);
    if ((blockIdx.x & 1) != 0) for (int item = blockIdx.x; item < 256; item += G) p0_fold_item(peer_w_q, peer_sub_keys, norm_ffn_g, W3T, item, (float*)smem);
    xcd_barrier(bar);
    }
    const bool xl = (G == 256) && (MISC[2] != 0u);
    const int vb = xl ? (int)((MISC[3] - 1u) * 8u + bar.x) : (int)blockIdx.x;

    for (int rep = 0; rep < REP1; ++rep) {
        pg8::Gemm g{XN, W1T, M, INW, D}; pg8::StaticOrder S; S.init(M, INW, G, vb);
        EpiProj E{Qb, Kb, Vb, UB, ctab, stab, rstd1};
        pg8::gemm_phase<EpiProj, pg8::StaticOrder, true, true>(lds, g, S, E);
        if (G == 256 && vb >= 192) {
            const int gw1 = (vb - 192) * NWAVES + wave;
            p0_tab4(peer_u, norm_ffn_g, u8, scl, 0, 0, TAB_P1, gw1, 64 * NWAVES, lane);
            p0_tab4(peer_v, nullptr, v8, scl, 1, 0, TAB_P1, gw1, 64 * NWAVES, lane);
        }
        xcd_barrier(bar);
    }

    for (int rep = 0; rep < REP2; ++rep) {
    for (int i = vb; i < M / 64; i += G) { const int u = (G % 8 == 0 && (M / 64) % 8 == 0) ? (i & 7) * (M / 64 / 8) + (i >> 3) : i; p2_attn_unit(Qb, Kb, Vb, attn_sinks, MIX, u, lds); }
    {
        float cwr[CK][2]; const int cp = tid & 255;
#pragma unroll
        for (int j = 0; j < CK; ++j) { const f32x2 w2 = *(const f32x2*)(conv_w + j * CC + 2 * cp); cwr[j][0] = w2[0]; cwr[j][1] = w2[1]; }
        const f32x2 cb2 = *(const f32x2*)(conv_b + 2 * cp);
        for (int i = vb; i < M / 32; i += G) { const int u = (G % 8 == 0) ? (i & 7) * (M / 32 / 8) + (i >> 3) : i; p2_conv_unit(UB, cwr, cb2[0], cb2[1], conv_ln_g, conv_ln_b, MIX, u, (float*)smem); }
    }
    if (xl) xcc_local_barrier(bar); else xcd_barrier(bar);
    }

    for (int rep = 0; rep < REP3; ++rep) {
        pg8::Gemm g{MIX, W2T, M, D, D}; pg8::StaticOrder S; S.init(M, D, G, vb);
        EpiRes E{XN, HB};
        pg8::gemm_phase<EpiRes, pg8::StaticOrder, true, true>(lds, g, S, E);
        if (xl) xcc_local_barrier(bar); else xcd_barrier(bar);
    }

    for (int rep = 0; rep < REP4; ++rep) {
        float* slot1 = (float*)(ws + WS_SC1) + (size_t)blockIdx.x * (2 * 32 * 256 * 4);
        pg8::Gemm g{HB, W3T, M, 2048, D}; pg8::StaticOrder S; S.init(M, 2048, G, vb);
        EpiScore E{slot, slot1};
        pg8::gemm_phase<EpiScore, pg8::StaticOrder, true, true>(lds, g, S, E);
        pg8::Unit u0, u1;
        const bool h0 = S.next(0, u0), h1 = S.next(1, u1);
        float* lst = (float*)smem;
        if (h0) p4_topk_lists(slot, lst);
        if (h1) p4_topk_lists(slot1, lst + 32 * 256);
        __syncthreads();
        unsigned res[48];
        const int hf = tid >> 8, tr = tid & 255;
        if (hf == 0) { if (h0) p4_topk_pairs(lst, tr, (const unsigned*)scl, res); }
        else         { if (h1) p4_topk_pairs(lst + 32 * 256, tr, (const unsigned*)scl, res); }
        __syncthreads();
        unsigned* stg = (unsigned*)smem + hf * (256 * STG_PITCH);
        if (hf == 0 ? h0 : h1) p4_stage(res, tr, stg);
        __syncthreads();
        if (hf == 0) { if (h0) p4_store(stg, tr, u0.pm * 256, u0.pn, ids, meta); }
        else         { if (h1) p4_store(stg, tr, u1.pm * 256, u1.pn, ids, meta); }
        __syncthreads();
        if (xl) xcc_local_barrier(bar); else xcd_barrier(bar);
    }

    for (int rep = 0; rep < REP5; ++rep) {
        int tid5 = threadIdx.x; asm volatile("" : "+v"(tid5));
        const int lane5 = tid5 & 63, wave5 = __builtin_amdgcn_readfirstlane(tid5 >> 6);
        const int x5 = vb & 7;
        const int gw5 = xl ? x5 * (M / 8) + (vb >> 3) * NWAVES + wave5 : (int)blockIdx.x * NWAVES + wave5;
        p5_peer(HB, ids, meta, u8, v8, final_norm_g, prm.out, gw5, xl ? (G / 8) * NWAVES : ngw, xl ? (x5 + 1) * (M / 8) : M, lane5, lds + wave5 * P5_WAVE_LDS2);
    }
}

extern "C" void kernel_launch(void* const* d_in, const int* in_sizes, int n_in, void* d_out, int out_size, void* d_ws, size_t ws_size, hipStream_t stream) {
    static int grid_blocks = 0;
    if (!grid_blocks) {
        int dev = 0, cus = 0, per_cu = 0;
        hipGetDevice(&dev);
        hipDeviceGetAttribute(&cus, hipDeviceAttributeMultiprocessorCount, dev);
        hipFuncSetAttribute((const void*)fwd_megakernel, hipFuncAttributeMaxDynamicSharedMemorySize, LDS_BYTES);
        hipOccupancyMaxActiveBlocksPerMultiprocessor(&per_cu, (const void*)fwd_megakernel, NT, LDS_BYTES);
        if (per_cu < 1) per_cu = 1;
        grid_blocks = cus * per_cu;
        fprintf(stderr, "grid: %d CUs x %d per CU, ws %zu\n", cus, per_cu, ws_size);
    }
    hipMemsetAsync((char*)d_ws + WS_CTL, 0, CTL_ZERO_BYTES, stream);
    Params p{};
    for (int i = 0; i < 17; ++i) p.in[i] = (const float*)d_in[i];
    p.out = (float*)d_out; p.ws = (unsigned char*)d_ws;
    void* args[] = {&p};
    hipError_t e = hipLaunchCooperativeKernel((const void*)fwd_megakernel, dim3(grid_blocks), dim3(NT), args, LDS_BYTES, stream);
    if (e != hipSuccess) fprintf(stderr, "cooperative launch failed: %s (grid %d)\n", hipGetErrorString(e), grid_blocks);
}
```

```cpp
#include <hip/hip_runtime.h>
#include <cstdio>
#include <cstdint>
namespace pg8 {
#define PG8_LAS __attribute__((address_space(3)))
typedef unsigned short bf16_t;
typedef short bf16x8 __attribute__((ext_vector_type(8)));
typedef float f32x4 __attribute__((ext_vector_type(4)));
typedef unsigned u32x4 __attribute__((ext_vector_type(4)));
constexpr int BM = 256, BK = 64, HALF = 128, HTB = HALF * BK * 2  , STAGE_BYTES = 8 * HTB, NXCD = 8, WGM = 8;

__host__ __device__ __forceinline__ int lds_byte(int r, int c) { const int st = (r >> 4) * 2 + (c >> 5), rr = r & 15, cc = c & 31, ob = rr * 64 + cc * 2; return st * 1024 + (ob ^ (((ob >> 9) & 1) << 5)); }
__host__ __device__ __forceinline__ void stage_rc(int b, int& R, int& C) { const int st = b / 1024, sb = b % 1024, swz = sb ^ (((sb >> 9) & 1) << 5); R = (st >> 1) * 16 + swz / 64; C = (st & 1) * 32 + (swz % 64) / 2; }
__host__ __device__ __forceinline__ int perm32(int rho) { const int n = rho >> 4, i = rho & 15; return 8 * (i >> 2) + 4 * n + (i & 3); }

struct Unit { int pm, pn, idx; };
struct Gemm { const bf16_t* A; const bf16_t* Bt; int M, N, K; };

struct StaticOrder {
    int nM, nN, nwg, G, c;
    __host__ __device__ void init(int M, int N, int G_, int c_) { nM = M / BM; nN = N / BM; nwg = nM * nN; G = G_; c = c_; }
    __host__ __device__ bool next(int i, Unit& u) const {
        const long L = (long)i * G + c; if (L >= nwg) return false;
        int wgid = (int)L; { const int q = nwg / NXCD, r = nwg % NXCD, xcd = wgid % NXCD, off = wgid / NXCD; wgid = (xcd < r ? xcd * (q + 1) : r * (q + 1) + (xcd - r) * q) + off; }
        const int nig = WGM * nN, gid = wgid / nig, fm = gid * WGM, gsz = (nM - fm) < WGM ? (nM - fm) : WGM;
        u.pm = fm + ((wgid % nig) % gsz); u.pn = (wgid % nig) / gsz; u.idx = i; return true;
    }
    __device__ __forceinline__ void a_ready(const Unit&) const {}
    __device__ __forceinline__ void done(const Unit&) const {}
};

__device__ __forceinline__ unsigned cvt_pk_bf16(float lo, float hi) { unsigned r; asm volatile("v_cvt_pk_bf16_f32 %0, %1, %2" : "=v"(r) : "v"(lo), "v"(hi)); return r; }
typedef float f32x2 __attribute__((ext_vector_type(2)));
typedef int fp8_i32x4 __attribute__((ext_vector_type(4)));
typedef int fp8_i32x8 __attribute__((ext_vector_type(8)));
__device__ __forceinline__ fp8_i32x8 cat8(bf16x8 lo, bf16x8 hi) { return __builtin_shufflevector(__builtin_bit_cast(fp8_i32x4, lo), __builtin_bit_cast(fp8_i32x4, hi), 0, 1, 2, 3, 4, 5, 6, 7); }
__device__ __forceinline__ void mfma_fp8_acc(f32x4& acc, const fp8_i32x8 a, const fp8_i32x8 b, const int scale) {
    asm volatile("v_mfma_scale_f32_16x16x128_f8f6f4 %0, %1, %2, %0, %3, %3 op_sel_hi:[0,0,0]" : "+v"(acc) : "v"(a), "v"(b), "v"(scale));
}
template <class Epi, class Sched, bool ALIGN_EPI = false, bool SP2 = false, bool FP8 = false>
__device__ __forceinline__ void gemm_phase(PG8_LAS unsigned char* lds, const Gemm g, const Sched& S, const Epi& E) {
    const int tid = threadIdx.x, wid = __builtin_amdgcn_readfirstlane(tid >> 6), lane = tid & 63, wr = wid >> 2, wc = wid & 3, fr = lane & 15, fq = lane >> 4;
    const int K = g.K, nt = K / BK;
    unsigned voffA[2], voffB[2];
#pragma unroll
    for (int i = 0; i < 2; ++i) { int R, C; stage_rc(tid * 16 + i * 8192, R, C); const int Rb = Epi::PERM ? ((R & ~31) + perm32(R & 31)) : R;
        voffA[i] = (unsigned)(R * K + C) * 2u; voffB[i] = (unsigned)(Rb * K + C) * 2u; }
    const size_t kstep = (size_t)(BK * 2);
    const size_t hstep = (size_t)HALF * K * 2;
    const size_t tstep = 2 * hstep;
    const unsigned ldsw = (unsigned)wid * 1024u;
    const int aoff = lds_byte(wr * 64 + fr, fq * 8), boff = lds_byte(wc * 32 + fr, fq * 8);
#define PG8_SA(b, h) (((b) * 2 + (h)) * HTB)
#define PG8_SB(b, h) ((4 + (b) * 2 + (h)) * HTB)
#define PG8_STAGE(bufoff, gbase, voff) do { _Pragma("unroll") for (int _i = 0; _i < 2; ++_i) \
        __builtin_amdgcn_global_load_lds((const unsigned*)((const char*)(gbase) + (voff)[_i]), (PG8_LAS unsigned*)(lds + (bufoff) + ldsw + _i * 8192), 16, 0, 0); } while (0)
#define PG8_LDA(dst, b, h) do { _Pragma("unroll") for (int m = 0; m < 4; ++m) _Pragma("unroll") for (int k = 0; k < 2; ++k) dst[m][k] = *(const PG8_LAS bf16x8*)(lds + PG8_SA(b, h) + aoff + m * 2048 + k * 1024); } while (0)
#define PG8_LDB(dst, b, h) do { _Pragma("unroll") for (int n = 0; n < 2; ++n) _Pragma("unroll") for (int k = 0; k < 2; ++k) dst[n][k] = *(const PG8_LAS bf16x8*)(lds + PG8_SB(b, h) + boff + n * 2048 + k * 1024); } while (0)
#define PG8_MMA(ai, bj, At, Bt) do { __builtin_amdgcn_s_setprio(1); \
        if constexpr (FP8) { _Pragma("unroll") for (int m = 0; m < 4; ++m) _Pragma("unroll") for (int n = 0; n < 2; ++n) \
            mfma_fp8_acc(acc[ai][bj][m][n], cat8(Bt[n][0], Bt[n][1]), cat8(At[m][0], At[m][1]), 0x7f7f7f7f); } \
        else { _Pragma("unroll") for (int m = 0; m < 4; ++m) _Pragma("unroll") for (int n = 0; n < 2; ++n) _Pragma("unroll") for (int k = 0; k < 2; ++k) \
            acc[ai][bj][m][n] = __builtin_amdgcn_mfma_f32_16x16x32_bf16(Bt[n][k], At[m][k], acc[ai][bj][m][n], 0, 0, 0); } \
        __builtin_amdgcn_s_setprio(0); } while (0)
#define PG8_WAIT_V(n) asm volatile("s_waitcnt vmcnt(" #n ")" ::: "memory")
#define PG8_WAIT_L(n) asm volatile("s_waitcnt lgkmcnt(" #n ")" ::: "memory")
#define PG8_BAR __builtin_amdgcn_s_barrier()
#define PG8_SCHED __builtin_amdgcn_sched_barrier(0)
    Unit cur, nxt; int ui = 0;
    if (!S.next(0, cur)) return;
    f32x4 acc[2][2][4][2];
#pragma unroll
    for (int a = 0; a < 2; ++a)
#pragma unroll
        for (int b = 0; b < 2; ++b)
#pragma unroll
            for (int m = 0; m < 4; ++m)
#pragma unroll
                for (int n = 0; n < 2; ++n) acc[a][b][m][n] = (f32x4){0.f, 0.f, 0.f, 0.f};
    bf16x8 At[4][2], B0[2][2], B1[2][2];
    const char* cA = (const char*)g.A + (size_t)cur.pm * tstep; const char* cB = (const char*)g.Bt + (size_t)cur.pn * tstep;
    S.a_ready(cur);
    if constexpr (SP2) {
        PG8_STAGE(PG8_SB(0, 0), cB, voffB); PG8_STAGE(PG8_SB(0, 1), cB + hstep, voffB); PG8_STAGE(PG8_SA(0, 0), cA, voffA); PG8_STAGE(PG8_SA(0, 1), cA + hstep, voffA);
        if (wr == 1) PG8_BAR;
        PG8_WAIT_V(2); PG8_BAR;
        PG8_STAGE(PG8_SB(1, 0), cB + kstep, voffB); PG8_STAGE(PG8_SA(1, 0), cA + kstep, voffA); PG8_STAGE(PG8_SB(1, 1), cB + hstep + kstep, voffB);
        PG8_WAIT_V(6); PG8_BAR;
    } else {
        PG8_STAGE(PG8_SB(0, 0), cB, voffB); PG8_STAGE(PG8_SA(0, 0), cA, voffA); PG8_STAGE(PG8_SB(0, 1), cB + hstep, voffB); PG8_STAGE(PG8_SA(0, 1), cA + hstep, voffA);
        if (wr == 1) PG8_BAR;
        PG8_WAIT_V(4); PG8_BAR;
        PG8_STAGE(PG8_SB(1, 0), cB + kstep, voffB); PG8_STAGE(PG8_SA(1, 0), cA + kstep, voffA); PG8_STAGE(PG8_SB(1, 1), cB + hstep + kstep, voffB);
        PG8_WAIT_V(6); PG8_BAR;
    }
    for (;;) {
        const bool has_next = S.next(ui + 1, nxt);
        const char* nA = has_next ? (const char*)g.A + (size_t)nxt.pm * tstep : cA; const char* nB = has_next ? (const char*)g.Bt + (size_t)nxt.pn * tstep : cB;
        for (int t = 0; t < nt; t += 2) {
            const bool last = (t == nt - 2);
            const char* a1 = cA + (size_t)(t + 1) * kstep;
            const char* a2 = last ? nA : cA + (size_t)(t + 2) * kstep; const char* b2 = last ? nB : cB + (size_t)(t + 2) * kstep;
            const char* a3 = a2 + kstep; const char* b3 = b2 + kstep;
            if (last && has_next) S.a_ready(nxt);
            if constexpr (SP2) {
            PG8_LDB(B0, 0, 0); PG8_LDB(B1, 0, 1); PG8_SCHED; PG8_LDA(At, 0, 0); PG8_STAGE(PG8_SA(1, 1), a1 + hstep, voffA);
            PG8_WAIT_V(8); PG8_WAIT_L(0); PG8_BAR; PG8_MMA(0, 0, At, B0); PG8_MMA(0, 1, At, B1); PG8_BAR; PG8_SCHED;
            PG8_LDA(At, 0, 1); PG8_STAGE(PG8_SB(0, 0), b2, voffB); PG8_STAGE(PG8_SB(0, 1), b2 + hstep, voffB); PG8_STAGE(PG8_SA(0, 0), a2, voffA);
            PG8_WAIT_V(8); PG8_WAIT_L(0); PG8_BAR; PG8_MMA(1, 0, At, B0); PG8_MMA(1, 1, At, B1); PG8_BAR; PG8_SCHED;
            PG8_LDB(B0, 1, 0); PG8_LDB(B1, 1, 1); PG8_SCHED; PG8_LDA(At, 1, 0); PG8_STAGE(PG8_SA(0, 1), a2 + hstep, voffA);
            PG8_WAIT_V(8); PG8_WAIT_L(0); PG8_BAR; PG8_MMA(0, 0, At, B0); PG8_MMA(0, 1, At, B1); PG8_BAR; PG8_SCHED;
            PG8_LDA(At, 1, 1); PG8_STAGE(PG8_SB(1, 0), b3, voffB); PG8_STAGE(PG8_SB(1, 1), b3 + hstep, voffB); PG8_STAGE(PG8_SA(1, 0), a3, voffA);
            PG8_WAIT_V(8); PG8_WAIT_L(0); PG8_BAR; PG8_MMA(1, 0, At, B0); PG8_MMA(1, 1, At, B1); PG8_BAR; PG8_SCHED;
            } else {
            PG8_LDB(B0, 0, 0); PG8_SCHED; PG8_LDA(At, 0, 0); PG8_STAGE(PG8_SA(1, 1), a1 + hstep, voffA);
            PG8_WAIT_L(8); PG8_BAR; PG8_WAIT_L(0); PG8_MMA(0, 0, At, B0); PG8_BAR; PG8_SCHED;
            PG8_LDB(B1, 0, 1); PG8_STAGE(PG8_SB(0, 0), b2, voffB);
            PG8_BAR; PG8_WAIT_L(0); PG8_MMA(0, 1, At, B1); PG8_BAR;
            PG8_LDA(At, 0, 1); PG8_STAGE(PG8_SA(0, 0), a2, voffA);
            PG8_BAR; PG8_WAIT_L(0); PG8_MMA(1, 0, At, B0); PG8_BAR; PG8_SCHED;
            PG8_STAGE(PG8_SB(0, 1), b2 + hstep, voffB);
            PG8_WAIT_V(6); PG8_BAR; PG8_MMA(1, 1, At, B1); PG8_BAR;
            PG8_LDB(B0, 1, 0); PG8_SCHED; PG8_LDA(At, 1, 0); PG8_STAGE(PG8_SA(0, 1), a2 + hstep, voffA);
            PG8_WAIT_L(8); PG8_BAR; PG8_WAIT_L(0); PG8_MMA(0, 0, At, B0); PG8_BAR; PG8_SCHED;
            PG8_LDB(B1, 1, 1); PG8_STAGE(PG8_SB(1, 0), b3, voffB);
            PG8_BAR; PG8_WAIT_L(0); PG8_MMA(0, 1, At, B1); PG8_BAR;
            PG8_LDA(At, 1, 1); PG8_STAGE(PG8_SA(1, 0), a3, voffA);
            PG8_BAR; PG8_WAIT_L(0); PG8_MMA(1, 0, At, B0); PG8_BAR; PG8_SCHED;
            PG8_STAGE(PG8_SB(1, 1), b3 + hstep, voffB);
            PG8_WAIT_V(6); PG8_BAR; PG8_MMA(1, 1, At, B1); PG8_BAR;
            }
        }
        if constexpr (ALIGN_EPI) { if (wr == 0) PG8_BAR; }
        if constexpr (!Epi::AFTER_DRAIN) { E(acc, cur, wr, wc, fr, fq); S.done(cur); }
        if (!has_next) break;
#pragma unroll
        for (int a = 0; a < 2; ++a)
#pragma unroll
            for (int b = 0; b < 2; ++b)
#pragma unroll
                for (int m = 0; m < 4; ++m)
#pragma unroll
                    for (int n = 0; n < 2; ++n) acc[a][b][m][n] = (f32x4){0.f, 0.f, 0.f, 0.f};
        cur = nxt; cA = nA; cB = nB; ++ui;
        if constexpr (ALIGN_EPI) { if (wr == 1) PG8_BAR; }
    }
    PG8_WAIT_V(0);
    if constexpr (!ALIGN_EPI) { if (wr == 0) PG8_BAR; }
    PG8_BAR;
    if constexpr (Epi::AFTER_DRAIN) { E.fused(acc, cur, wr, wc, fr, fq, lds, wid, lane); S.done(cur); }
#undef PG8_SA
#undef PG8_SB
#undef PG8_STAGE
#undef PG8_LDA
#undef PG8_LDB
#undef PG8_MMA
#undef PG8_WAIT_V
#undef PG8_WAIT_L
#undef PG8_BAR
#undef PG8_SCHED
}
}

#define REP0 1
#define REP1 1
#define REP2 1
#define REP3 1
#define REP4 1
#define REP5 1
#define REPTK 1
#define LAS __attribute__((address_space(3)))
typedef unsigned short bf16;
typedef float f32x2 __attribute__((ext_vector_type(2)));
typedef float f32x4 __attribute__((ext_vector_type(4)));
typedef unsigned u32x2 __attribute__((ext_vector_type(2)));
typedef unsigned u32x4 __attribute__((ext_vector_type(4)));

constexpr int BATCH = 8, SEQ = 2048, D = 1024, M = BATCH * SEQ;
constexpr int INW = 1792, CC = 512, CK = 31, WIN = 128;
constexpr int NK = 128, TOPK = 16, NE = 16384;
constexpr float W2_SCALE = 256.0f;
constexpr int TAB_P1 = 8192;
constexpr float EPS = 1e-6f;
constexpr int NT = 512, NWAVES = 8;
constexpr int LDS_BYTES = 147456;
constexpr int MISC_OFF = 131072 + 64;

constexpr size_t MiB = 1u << 20;
constexpr size_t WS_CTL = 0;
constexpr size_t CTL_ZERO_BYTES = 49152;
constexpr size_t WS_W1T = 2 * MiB;
constexpr size_t WS_W2T = 6 * MiB;
constexpr size_t WS_W3T = 8 * MiB;
constexpr size_t WS_HB8 = 144 * MiB;
constexpr float W3_SCALE = 256.0f;
constexpr size_t WS_ROPE = 12 * MiB;
constexpr size_t WS_SCL = 13 * MiB;
constexpr size_t WS_U8 = 16 * MiB;
constexpr size_t WS_V8 = 32 * MiB;
constexpr size_t WS_XN = 48 * MiB;
constexpr size_t WS_MIX = 120 * MiB;
constexpr size_t WS_RSTD1 = 14 * MiB;
constexpr size_t WS_Q = 80 * MiB;
constexpr size_t WS_K = 96 * MiB;
constexpr size_t WS_V = 100 * MiB;
constexpr size_t WS_UB = 104 * MiB;
constexpr size_t WS_HB = 184 * MiB;
constexpr size_t WS_IDS = 216 * MiB;
constexpr size_t WS_META = 224 * MiB;
constexpr size_t WS_SC = 136 * MiB;

typedef __bf16 bf16x2_t __attribute__((ext_vector_type(2)));
__device__ __forceinline__ unsigned pk2(float lo, float hi) { const f32x2 v = {lo, hi}; return __builtin_bit_cast(unsigned, __builtin_convertvector(v, bf16x2_t)); }
__device__ __forceinline__ unsigned f2bf(float f) { return pk2(f, 0.f) & 0xffffu; }
__device__ __forceinline__ float bflo(unsigned w) { return __builtin_bit_cast(float, w << 16); }
__device__ __forceinline__ float bfhi(unsigned w) { return __builtin_bit_cast(float, w & 0xffff0000u); }
__device__ __forceinline__ float wave_sum(float v) {
#pragma unroll
    for (int o = 1; o < 64; o <<= 1) v += __shfl_xor(v, o);
    return v;
}
__device__ __forceinline__ void wave_sum4(float (&v)[4]) {
#pragma unroll
    for (int o = 1; o < 64; o <<= 1) { float t[4];
#pragma unroll
        for (int i = 0; i < 4; ++i) t[i] = __shfl_xor(v[i], o);
#pragma unroll
        for (int i = 0; i < 4; ++i) v[i] += t[i]; }
}

struct EpiProj {
    static constexpr bool PERM = true, AFTER_DRAIN = false;
    bf16 *Q, *K, *V, *U; const float *ctab, *stab, *rstd;
    __device__ __forceinline__ void operator()(const pg8::f32x4 (&acc)[2][2][4][2], const pg8::Unit& u, int wr, int wc, int fr, int fq) const {
        const int pn = u.pn, row0 = u.pm * 256 + wr * 64 + fr;
        if (pn <= 2) {
#pragma unroll
            for (int bj = 0; bj < 2; ++bj) {
                if (pn == 2 && bj == 1) {
#pragma unroll
                    for (int ai = 0; ai < 2; ++ai)
#pragma unroll
                        for (int m = 0; m < 4; ++m) {
                            const int row = row0 + ai * 128 + m * 16, bb = row >> 11, s = row & (SEQ - 1);
                            const float rsr = rstd[row];
#pragma unroll
                            for (int n = 0; n < 2; ++n) { const pg8::f32x4 a = acc[ai][1][m][n] * rsr;
                                bf16* vp = V + ((size_t)(bb * 2 + (wc >> 1)) * 64 + (wc & 1) * 32 + fq * 8 + n * 4) * SEQ + s;
#pragma unroll
                                for (int j = 0; j < 4; ++j) vp[(size_t)j * SEQ] = (bf16)f2bf(a[j]); }
                        }
                } else {
                    bf16* base; int ld, colh; float sc;
                    if (pn < 2) { base = Q; ld = 512; colh = (4 * pn + 2 * bj + (wc >> 1)) * 64; sc = 0.125f * 1.44269504089f; }
                    else { base = K; ld = 128; colh = (wc >> 1) * 64; sc = 1.0f; }
                    const int i0 = 16 * (wc & 1) + 4 * fq;
#pragma unroll
                    for (int ai = 0; ai < 2; ++ai)
#pragma unroll
                        for (int m = 0; m < 4; ++m) {
                            const int row = row0 + ai * 128 + m * 16, pos = row & (SEQ - 1);
                            const pg8::f32x4 c = *(const pg8::f32x4*)(ctab + pos * 32 + i0), s = *(const pg8::f32x4*)(stab + pos * 32 + i0);
                            const pg8::f32x4 x1 = acc[ai][bj][m][0], x2 = acc[ai][bj][m][1];
                            const float scr = sc * rstd[row];
                            const pg8::f32x4 o1 = (x1 * c - x2 * s) * scr, o2 = (x2 * c + x1 * s) * scr;
                            u32x2 w1, w2; w1.x = pk2(o1[0], o1[1]); w1.y = pk2(o1[2], o1[3]); w2.x = pk2(o2[0], o2[1]); w2.y = pk2(o2[2], o2[3]);
                            bf16* p = base + (size_t)row * ld + colh + i0;
                            *(u32x2*)p = w1; *(u32x2*)(p + 32) = w2;
                        }
                }
            }
        } else {
            const int ch0 = 128 * (pn - 3) + 32 * wc + 8 * fq;
#pragma unroll
            for (int ai = 0; ai < 2; ++ai)
#pragma unroll
                for (int m = 0; m < 4; ++m) {
                    const float rsr = rstd[row0 + ai * 128 + m * 16];
                    float o[8];
#pragma unroll
                    for (int n = 0; n < 2; ++n) {
                        const pg8::f32x4 a = acc[ai][0][m][n] * rsr, b = acc[ai][1][m][n] * rsr;
#pragma unroll
                        for (int j = 0; j < 4; ++j) o[4 * n + j] = a[j] * __builtin_amdgcn_rcpf(1.0f + __builtin_amdgcn_exp2f(b[j] * -1.44269504089f));
                    }
                    u32x4 w; w.x = pk2(o[0], o[1]); w.y = pk2(o[2], o[3]); w.z = pk2(o[4], o[5]); w.w = pk2(o[6], o[7]);
                    *(u32x4*)(U + (size_t)(row0 + ai * 128 + m * 16) * 512 + ch0) = w;
                }
        }
    }
};
struct EpiRes {
    static constexpr bool PERM = true, AFTER_DRAIN = false;
    const bf16* x; bf16* HB; unsigned char* HB8;
    __device__ __forceinline__ void operator()(const pg8::f32x4 (&acc)[2][2][4][2], const pg8::Unit& u, int wr, int wc, int fr, int fq) const {
        const int row0 = u.pm * 256 + wr * 64 + fr, col0 = u.pn * 256 + wc * 32 + fq * 8;
#pragma unroll
        for (int ai = 0; ai < 2; ++ai)
#pragma unroll
            for (int m = 0; m < 4; ++m)
#pragma unroll
                for (int bj = 0; bj < 2; ++bj) {
                    const size_t off = (size_t)(row0 + ai * 128 + m * 16) * D + col0 + bj * 128;
                    const u32x4 xw = *(const u32x4*)(x + off);
                    const pg8::f32x4 o0 = (pg8::f32x4){bflo(xw.x), bfhi(xw.x), bflo(xw.y), bfhi(xw.y)} + acc[ai][bj][m][0] * (1.0f / W2_SCALE);
                    const pg8::f32x4 o1 = (pg8::f32x4){bflo(xw.z), bfhi(xw.z), bflo(xw.w), bfhi(xw.w)} + acc[ai][bj][m][1] * (1.0f / W2_SCALE);
                    u32x4 w; w.x = pk2(o0[0], o0[1]); w.y = pk2(o0[2], o0[3]); w.z = pk2(o1[0], o1[1]); w.w = pk2(o1[2], o1[3]);
                    *(u32x4*)(HB + off) = w;
                    int b0 = 0, b1 = 0;
                    b0 = __builtin_amdgcn_cvt_pk_fp8_f32(o0[0], o0[1], b0, false); b0 = __builtin_amdgcn_cvt_pk_fp8_f32(o0[2], o0[3], b0, true);
                    b1 = __builtin_amdgcn_cvt_pk_fp8_f32(o1[0], o1[1], b1, false); b1 = __builtin_amdgcn_cvt_pk_fp8_f32(o1[2], o1[3], b1, true);
                    *(u32x2*)(HB8 + off) = (u32x2){(unsigned)b0, (unsigned)b1};
                }
    }
};
typedef _Float16 f16x2s __attribute__((ext_vector_type(2)));
__device__ __forceinline__ unsigned pk_f16(float a, float b) { const f16x2s h = {(_Float16)a, (_Float16)b}; return __builtin_bit_cast(unsigned, h); }
struct EpiScoreLds {
    static constexpr bool PERM = false, AFTER_DRAIN = true;
    __device__ __forceinline__ void fused(const pg8::f32x4 (&acc)[2][2][4][2], const pg8::Unit&, int wr, int wc, int fr, int fq, PG8_LAS unsigned char* lds, int, int) const {
        PG8_LAS unsigned char* base = lds + wc * 16384 + fq * 4096 + wr * 1024 + fr * 16;
#pragma unroll
        for (int ai = 0; ai < 2; ++ai)
#pragma unroll
            for (int m = 0; m < 4; ++m)
#pragma unroll
                for (int bj = 0; bj < 2; ++bj) {
                    const pg8::f32x4 a0 = acc[ai][bj][m][0] * (1.0f / W3_SCALE), a1 = acc[ai][bj][m][1] * (1.0f / W3_SCALE);
                    const u32x4 w = {pk_f16(a0[0], a0[1]), pk_f16(a0[2], a0[3]), pk_f16(a1[0], a1[1]), pk_f16(a1[2], a1[3])};
                    *(PG8_LAS u32x4*)(base + bj * 65536 + ai * 2048 + m * 256) = w;
                }
    }
};
struct RoundOrder {
    pg8::StaticOrder S; int round;
    __device__ bool next(int i, pg8::Unit& u) const { return i == 0 && S.next(round, u); }
    __device__ __forceinline__ void a_ready(const pg8::Unit&) const {}
    __device__ __forceinline__ void done(const pg8::Unit&) const {}
};

__device__ __forceinline__ int swap45(int v) { return (v & ~48) | ((v & 16) << 1) | ((v & 32) >> 1); }
__device__ __forceinline__ int w1_src_col(int p) {
    if (p < 640) { const int pp = p & 63, w = pp >> 5, q = pp & 31;
        return (p & ~63) | (32 * ((q >> 2) & 1) + 16 * w + 4 * (q >> 3) + (q & 3)); }
    if (p < 768) return p;
    const int t = (p - 768) >> 8, c = (p - 768) & 255;
    return ((c & 128) ? 1280 : 768) + 128 * t + (c & 127);
}
template <int MODE>
__device__ __forceinline__ void p0_transpose(const float* __restrict__ W, int nsrc, int nrows, bf16* __restrict__ WT, const float* __restrict__ g0, const float* __restrict__ g1, int gtid, int gthreads) {
    const int total = nrows * 128;
    for (int it = gtid; it < total; it += gthreads) {
        const int p = it % nrows, kc = it / nrows, L = (MODE == 0) ? w1_src_col(p) : p;
        float v[8];
#pragma unroll
        for (int j = 0; j < 8; ++j) { const int k = kc * 8 + j; float a = W[(size_t)k * nsrc + L];
            if (MODE == 1) a *= (k < 512) ? g0[k] : g1[k - 512];
            else a *= g0[k];
            v[j] = a; }
        if (MODE == 1) {
            int w0 = 0, w1 = 0;
            w0 = __builtin_amdgcn_cvt_pk_fp8_f32(v[0] * W2_SCALE, v[1] * W2_SCALE, w0, false); w0 = __builtin_amdgcn_cvt_pk_fp8_f32(v[2] * W2_SCALE, v[3] * W2_SCALE, w0, true);
            w1 = __builtin_amdgcn_cvt_pk_fp8_f32(v[4] * W2_SCALE, v[5] * W2_SCALE, w1, false); w1 = __builtin_amdgcn_cvt_pk_fp8_f32(v[6] * W2_SCALE, v[7] * W2_SCALE, w1, true);
            *(u32x2*)((unsigned char*)WT + (size_t)p * D + kc * 8) = (u32x2){(unsigned)w0, (unsigned)w1};
        } else {
        u32x4 o; o.x = pk2(v[0], v[1]); o.y = pk2(v[2], v[3]); o.z = pk2(v[4], v[5]); o.w = pk2(v[6], v[7]);
        *(u32x4*)(WT + (size_t)p * D + kc * 8) = o;
        }
    }
}
typedef float f32x16 __attribute__((ext_vector_type(16)));
__device__ __forceinline__ void p0_fold_item(const float* __restrict__ wq, const float* __restrict__ sk, const float* __restrict__ gffn, bf16* __restrict__ W3T, int item, float* lds) {
    const int hp = item >> 4, k0 = (item & 15) * 64, t = threadIdx.x, lane = t & 63, wave = t >> 6;
    float* sks = lds;
    float* wqs = lds + 128 * 129;
    for (int i = t; i < 128 * 32; i += NT) { const int key = i >> 5, c4 = i & 31;
        const float4 v = *(const float4*)(sk + ((size_t)hp * 128 + key) * 128 + c4 * 4); float* d = sks + key * 129 + c4 * 4; d[0] = v.x; d[1] = v.y; d[2] = v.z; d[3] = v.w; }
    for (int i = t; i < 64 * 32; i += NT) { const int kk = i >> 5, c4 = i & 31;
        const float4 v = *(const float4*)(wq + (size_t)(k0 + kk) * 2048 + hp * 128 + c4 * 4); float* d = wqs + kk * 129 + c4 * 4; d[0] = v.x; d[1] = v.y; d[2] = v.z; d[3] = v.w; }
    __syncthreads();
    const int ti = wave >> 2, tj = wave & 3, l31 = lane & 31, lh = lane >> 5;
    const float* ap = wqs + (32 * ti + l31) * 129 + lh;
    const float* bp = sks + (32 * tj + l31) * 129 + lh;
    f32x16 acc;
#pragma unroll
    for (int i = 0; i < 16; ++i) acc[i] = 0.f;
#pragma unroll 8
    for (int s = 0; s < 64; ++s) acc = __builtin_amdgcn_mfma_f32_32x32x2f32(ap[2 * s], bp[2 * s], acc, 0, 0, 0);
    unsigned char* dst = (unsigned char*)W3T + (size_t)(hp * 128 + 32 * tj + l31) * D + k0 + 32 * ti + 4 * lh;
    const float* g = gffn + k0 + 32 * ti + 4 * lh;
#pragma unroll
    for (int q = 0; q < 4; ++q) { int w = 0;
        w = __builtin_amdgcn_cvt_pk_fp8_f32(acc[4 * q] * g[8 * q] * W3_SCALE, acc[4 * q + 1] * g[8 * q + 1] * W3_SCALE, w, false);
        w = __builtin_amdgcn_cvt_pk_fp8_f32(acc[4 * q + 2] * g[8 * q + 2] * W3_SCALE, acc[4 * q + 3] * g[8 * q + 3] * W3_SCALE, w, true);
        *(int*)(dst + 8 * q) = w; }
    __syncthreads();
}
constexpr int RB = 4;
__device__ __forceinline__ void p0_xn(const float* __restrict__ x, bf16* __restrict__ xb, float* __restrict__ rstd1, int gw, int ngw, int lane) {
    for (int r0 = gw * RB; r0 < M; r0 += ngw * RB) {
        float4 v[RB][4];
#pragma unroll
        for (int i = 0; i < RB; ++i)
#pragma unroll
            for (int j = 0; j < 4; ++j) v[i][j] = ((const float4*)(x + (size_t)(r0 + i) * D))[lane + 64 * j];
#pragma unroll
        for (int i = 0; i < RB; ++i) {
            float s = 0.f;
            u32x2* o = (u32x2*)(xb + (size_t)(r0 + i) * D);
#pragma unroll
            for (int j = 0; j < 4; ++j) { s += v[i][j].x * v[i][j].x + v[i][j].y * v[i][j].y + v[i][j].z * v[i][j].z + v[i][j].w * v[i][j].w;
                u32x2 w; w.x = pk2(v[i][j].x, v[i][j].y); w.y = pk2(v[i][j].z, v[i][j].w); o[lane + 64 * j] = w; }
            s = wave_sum(s);
            if (lane == 0) rstd1[r0 + i] = 1.0f / sqrtf(s * (1.0f / D) + EPS);
        }
    }
}
__device__ __forceinline__ void p0_tab4(const float* __restrict__ tab, const float* __restrict__ gain, unsigned char* __restrict__ t4, bf16* __restrict__ scl, int which, int row_lo, int row_hi, int gw, int ngw, int lane) {
    float4 gg[4];
#pragma unroll
    for (int j = 0; j < 4; ++j) gg[j] = gain ? ((const float4*)gain)[lane + 64 * j] : make_float4(1.f, 1.f, 1.f, 1.f);
    for (int r0 = row_lo + gw * RB; r0 < row_hi; r0 += ngw * RB) {
        float4 a[RB][4];
#pragma unroll
        for (int i = 0; i < RB; ++i)
#pragma unroll
            for (int j = 0; j < 4; ++j) a[i][j] = ((const float4*)(tab + (size_t)(r0 + i) * D))[lane + 64 * j];
#pragma unroll
        for (int i = 0; i < RB; ++i) {
            float ss = 0.f;
#pragma unroll
            for (int j = 0; j < 4; ++j) {
                a[i][j].x *= gg[j].x; a[i][j].y *= gg[j].y; a[i][j].z *= gg[j].z; a[i][j].w *= gg[j].w;
                ss += a[i][j].x * a[i][j].x + a[i][j].y * a[i][j].y + a[i][j].z * a[i][j].z + a[i][j].w * a[i][j].w; }
            const float rms = fmaxf(sqrtf(wave_sum(ss) * (1.0f / D)), 1e-30f);
            const float sc = 2.0f / rms;
            u32x2 w;
#pragma unroll
            for (int d = 0; d < 2; ++d) { unsigned t = 0u;
                t = __builtin_amdgcn_cvt_scalef32_pk_fp4_f32(t, a[i][2 * d].x * sc, a[i][2 * d].y * sc, 1.0f, 0);
                t = __builtin_amdgcn_cvt_scalef32_pk_fp4_f32(t, a[i][2 * d].z * sc, a[i][2 * d].w * sc, 1.0f, 1);
                t = __builtin_amdgcn_cvt_scalef32_pk_fp4_f32(t, a[i][2 * d + 1].x * sc, a[i][2 * d + 1].y * sc, 1.0f, 2);
                t = __builtin_amdgcn_cvt_scalef32_pk_fp4_f32(t, a[i][2 * d + 1].z * sc, a[i][2 * d + 1].w * sc, 1.0f, 3);
                w[d] = t; }
            ((u32x2*)(t4 + (size_t)(r0 + i) * 512))[lane] = w;
            if (lane == 0) scl[2 * (r0 + i) + which] = (bf16)f2bf(rms * 0.5f);
        }
    }
}

constexpr int KS_PITCH = 144, VT_PITCH = 400, KS_BYTES = 2 * 192 * KS_PITCH, VT_BYTES = 2 * 64 * VT_PITCH;
__device__ __forceinline__ void p2_attn_unit(const bf16* __restrict__ Q, const bf16* __restrict__ K, const bf16* __restrict__ Vt, const float* __restrict__ sinks, unsigned char* __restrict__ MIX,
                                             int unit, LAS unsigned char* lds) {
    const int t = threadIdx.x, lane = t & 63, wave = __builtin_amdgcn_readfirstlane(t >> 6), fr = lane & 15, fq = lane >> 4;
    const int bb = unit >> 5, q0 = (unit & 31) * 64;
    const int rowq0 = bb * SEQ + q0, k0pos = q0 - 128;
    LAS unsigned char* Ks = lds; LAS unsigned char* Vts = lds + KS_BYTES; LAS float* ssq = (LAS float*)(lds + KS_BYTES + VT_BYTES);
#pragma unroll
    for (int i = 0; i < 6; ++i) {
        const int idx = t + 512 * i, kj = idx >> 4, c = idx & 15, pos = k0pos + kj;
        u32x4 v = {0u, 0u, 0u, 0u};
        if (pos >= 0) v = *(const u32x4*)(K + (size_t)(bb * SEQ + pos) * 128 + c * 8);
        *(LAS u32x4*)(Ks + ((c >> 3) * 192 + kj) * KS_PITCH + (c & 7) * 16) = v;
    }
#pragma unroll
    for (int i = 0; i < 6; ++i) {
        const int idx = t + 512 * i, r = idx / 24, c = idx - r * 24, pos = k0pos + c * 8;
        u32x4 v = {0u, 0u, 0u, 0u};
        if (pos >= 0) v = *(const u32x4*)(Vt + ((size_t)bb * 128 + r) * SEQ + pos);
        *(LAS u32x4*)(Vts + r * VT_PITCH + c * 16) = v;
    }
    const int hq = wave, kvh = hq >> 2;
    pg8::bf16x8 qf[4][2];
#pragma unroll
    for (int g = 0; g < 4; ++g)
#pragma unroll
        for (int ks = 0; ks < 2; ++ks) qf[g][ks] = *(const pg8::bf16x8*)(Q + (size_t)(rowq0 + 16 * g + fr) * 512 + hq * 64 + ks * 32 + fq * 8);
    const float sink2 = sinks[hq] * 1.44269504089f;
    const int kmin = -k0pos;
    __syncthreads();
    pg8::f32x4 o[4][4];
    LAS unsigned char* Kw = Ks + kvh * 192 * KS_PITCH + fr * KS_PITCH + fq * 16;
    LAS unsigned char* Vw = Vts + (kvh * 64 + fr) * VT_PITCH + fq * 8;
    const int dl = fr - 4 * fq;
#pragma unroll
    for (int gp = 0; gp < 2; ++gp) {
        pg8::f32x4 s[2][10];
        float mx[2] = {sink2, sink2};
#pragma unroll
        for (int jt = 0; jt < 10; ++jt) {
            s[0][jt] = (pg8::f32x4){0.f, 0.f, 0.f, 0.f}; s[1][jt] = (pg8::f32x4){0.f, 0.f, 0.f, 0.f};
#pragma unroll
            for (int ks = 0; ks < 2; ++ks) {
                const pg8::bf16x8 kf = *(const LAS pg8::bf16x8*)(Kw + (2 * gp + jt) * 16 * KS_PITCH + ks * 64);
                if (jt <= 8) s[0][jt] = __builtin_amdgcn_mfma_f32_16x16x32_bf16(kf, qf[2 * gp][ks], s[0][jt], 0, 0, 0);
                if (jt >= 1) s[1][jt] = __builtin_amdgcn_mfma_f32_16x16x32_bf16(kf, qf[2 * gp + 1][ks], s[1][jt], 0, 0, 0);
            }
        }
#pragma unroll
        for (int e = 0; e < 2; ++e)
#pragma unroll
            for (int jt = e; jt <= e + 8; ++jt)
#pragma unroll
                for (int r = 0; r < 4; ++r) {
                    float v = s[e][jt][r];
                    if (jt == e) v = (dl - r < 0) ? v : -1.0e30f;
                    if (jt == e + 8) v = (dl - r >= 0) ? v : -1.0e30f;
                    if (kmin > 0) v = (16 * (2 * gp + jt) + 4 * fq + r >= kmin) ? v : -1.0e30f;
                    s[e][jt][r] = v; mx[e] = fmaxf(mx[e], v);
                }
        float l[2] = {0.f, 0.f};
#pragma unroll
        for (int e = 0; e < 2; ++e) { mx[e] = fmaxf(mx[e], __shfl_xor(mx[e], 16)); }
#pragma unroll
        for (int e = 0; e < 2; ++e) { mx[e] = fmaxf(mx[e], __shfl_xor(mx[e], 32)); }
#pragma unroll
        for (int e = 0; e < 2; ++e)
#pragma unroll
            for (int jt = e; jt <= e + 8; ++jt)
#pragma unroll
                for (int r = 0; r < 4; ++r) { const float p = __builtin_amdgcn_exp2f(s[e][jt][r] - mx[e]); s[e][jt][r] = p; l[e] += p; }
#pragma unroll
        for (int e = 0; e < 2; ++e) l[e] += __shfl_xor(l[e], 16);
#pragma unroll
        for (int e = 0; e < 2; ++e) l[e] += __shfl_xor(l[e], 32);
#pragma unroll
        for (int e = 0; e < 2; ++e)
#pragma unroll
            for (int dt = 0; dt < 4; ++dt) o[2 * gp + e][dt] = (pg8::f32x4){0.f, 0.f, 0.f, 0.f};
#pragma unroll
        for (int sp = 0; sp < 5; ++sp) {
            pg8::bf16x8 pf[2];
#pragma unroll
            for (int e = 0; e < 2; ++e) { u32x4 pw; pw.x = pk2(s[e][2 * sp][0], s[e][2 * sp][1]); pw.y = pk2(s[e][2 * sp][2], s[e][2 * sp][3]);
                pw.z = pk2(s[e][2 * sp + 1][0], s[e][2 * sp + 1][1]); pw.w = pk2(s[e][2 * sp + 1][2], s[e][2 * sp + 1][3]); pf[e] = __builtin_bit_cast(pg8::bf16x8, pw); }
#pragma unroll
            for (int dt = 0; dt < 4; ++dt) {
                const LAS unsigned char* vp = Vw + dt * 16 * VT_PITCH + (gp + sp) * 64;
                u32x4 vw; const u32x2 lo = *(const LAS u32x2*)vp, hi = *(const LAS u32x2*)(vp + 32); vw.x = lo.x; vw.y = lo.y; vw.z = hi.x; vw.w = hi.y;
                const pg8::bf16x8 vf = __builtin_bit_cast(pg8::bf16x8, vw);
                o[2 * gp][dt] = __builtin_amdgcn_mfma_f32_16x16x32_bf16(vf, pf[0], o[2 * gp][dt], 0, 0, 0);
                o[2 * gp + 1][dt] = __builtin_amdgcn_mfma_f32_16x16x32_bf16(vf, pf[1], o[2 * gp + 1][dt], 0, 0, 0);
            }
        }
#pragma unroll
        for (int e = 0; e < 2; ++e) {
            const int g = 2 * gp + e;
            const float il = __builtin_amdgcn_rcpf(l[e] + __builtin_amdgcn_exp2f(sink2 - mx[e]));
            float sq = 0.f;
#pragma unroll
            for (int dt = 0; dt < 4; ++dt) { o[g][dt] = o[g][dt] * il; sq += o[g][dt][0] * o[g][dt][0] + o[g][dt][1] * o[g][dt][1] + o[g][dt][2] * o[g][dt][2] + o[g][dt][3] * o[g][dt][3]; }
            sq += __shfl_xor(sq, 16); sq += __shfl_xor(sq, 32);
            if (fq == 0) ssq[wave * 64 + 16 * g + fr] = sq;
        }
    }
    __syncthreads();
#pragma unroll
    for (int g = 0; g < 4; ++g) {
        float tot = 0.f;
#pragma unroll
        for (int w = 0; w < 8; ++w) tot += ssq[w * 64 + 16 * g + fr];
        const float rs = 1.0f / sqrtf(tot * (1.0f / 512.0f) + EPS);
#pragma unroll
        for (int dt = 0; dt < 4; ++dt) { const pg8::f32x4 v = o[g][dt] * rs; int w8 = 0;
            w8 = __builtin_amdgcn_cvt_pk_fp8_f32(v[0], v[1], w8, false); w8 = __builtin_amdgcn_cvt_pk_fp8_f32(v[2], v[3], w8, true);
            *(int*)(MIX + (size_t)(rowq0 + 16 * g + fr) * D + hq * 64 + dt * 16 + fq * 4) = w8; }
    }
    __syncthreads();
}

constexpr int YP = 520;
__device__ __forceinline__ void p2_conv_unit(const bf16* __restrict__ U, const float (&w)[CK][2], const float b0, const float b1, const float* __restrict__ lng, const float* __restrict__ lnb,
                                             unsigned char* __restrict__ MIX, int unit, float* ybuf) {
    const int t = threadIdx.x, lane = t & 63, wave = __builtin_amdgcn_readfirstlane(t >> 6), cp = t & 255, hf = t >> 8;
    const int bb = unit >> 6, t0 = (unit & 63) * 32;
    const int tb = t0 + 16 * hf;
    float acc[16][2];
#pragma unroll
    for (int o = 0; o < 16; ++o) { acc[o][0] = b0; acc[o][1] = b1; }
    const bf16* up = U + (size_t)bb * SEQ * 512 + 2 * cp;
#pragma unroll
    for (int rr = 0; rr < 46; ++rr) {
        const int tp = tb - 30 + rr;
        unsigned uw = 0u;
        if (tp >= 0) uw = *(const unsigned*)(up + (size_t)tp * 512);
        const float u0 = bflo(uw), u1 = bfhi(uw);
#pragma unroll
        for (int o = 0; o < 16; ++o) { const int j = rr - o; if (j >= 0 && j < CK) { acc[o][0] += w[j][0] * u0; acc[o][1] += w[j][1] * u1; } }
    }
#pragma unroll
    for (int o = 0; o < 16; ++o) *(f32x2*)(ybuf + (16 * hf + o) * YP + 2 * cp) = (f32x2){acc[o][0], acc[o][1]};
    __syncthreads();
    const int c8 = lane * 8;
    const f32x4 g0 = *(const f32x4*)(lng + c8), g1 = *(const f32x4*)(lng + c8 + 4), e0 = *(const f32x4*)(lnb + c8), e1 = *(const f32x4*)(lnb + c8 + 4);
    const float gg[8] = {g0[0], g0[1], g0[2], g0[3], g1[0], g1[1], g1[2], g1[3]}, ee[8] = {e0[0], e0[1], e0[2], e0[3], e1[0], e1[1], e1[2], e1[3]};
    float y[4][8], red[4];
#pragma unroll
    for (int i = 0; i < 4; ++i) {
        const f32x4 ya = *(const f32x4*)(ybuf + (wave * 4 + i) * YP + c8), yb = *(const f32x4*)(ybuf + (wave * 4 + i) * YP + c8 + 4);
        y[i][0] = ya[0]; y[i][1] = ya[1]; y[i][2] = ya[2]; y[i][3] = ya[3]; y[i][4] = yb[0]; y[i][5] = yb[1]; y[i][6] = yb[2]; y[i][7] = yb[3];
        red[i] = 0.f;
#pragma unroll
        for (int k = 0; k < 8; ++k) red[i] += y[i][k];
    }
    wave_sum4(red);
#pragma unroll
    for (int i = 0; i < 4; ++i) { const float mu = red[i] * (1.0f / CC); red[i] = 0.f;
#pragma unroll
        for (int k = 0; k < 8; ++k) { y[i][k] -= mu; red[i] += y[i][k] * y[i][k]; } }
    wave_sum4(red);
#pragma unroll
    for (int i = 0; i < 4; ++i) { const float rstd = 1.0f / sqrtf(red[i] * (1.0f / CC) + EPS); red[i] = 0.f;
#pragma unroll
        for (int k = 0; k < 8; ++k) { const float z = y[i][k] * rstd * gg[k] + ee[k]; const float a = z * __builtin_amdgcn_rcpf(1.0f + __builtin_amdgcn_exp2f(z * -1.44269504089f)); y[i][k] = a; red[i] += a * a; } }
    wave_sum4(red);
#pragma unroll
    for (int i = 0; i < 4; ++i) { const float rs = 1.0f / sqrtf(red[i] * (1.0f / CC) + EPS);
        u32x2 ow; int w8 = 0;
        w8 = __builtin_amdgcn_cvt_pk_fp8_f32(y[i][0] * rs, y[i][1] * rs, w8, false); w8 = __builtin_amdgcn_cvt_pk_fp8_f32(y[i][2] * rs, y[i][3] * rs, w8, true); ow.x = (unsigned)w8;
        w8 = __builtin_amdgcn_cvt_pk_fp8_f32(y[i][4] * rs, y[i][5] * rs, w8, false); w8 = __builtin_amdgcn_cvt_pk_fp8_f32(y[i][6] * rs, y[i][7] * rs, w8, true); ow.y = (unsigned)w8;
        *(u32x2*)(MIX + (size_t)(bb * SEQ + t0 + wave * 4 + i) * D + 512 + c8) = ow; }
    __syncthreads();
}

__device__ __forceinline__ void ins16(float (&t)[16], const float x) {
#pragma unroll
    for (int i = 15; i >= 1; --i) t[i] = __builtin_amdgcn_fmed3f(t[i - 1], t[i], x);
    t[0] = fmaxf(t[0], x);
}
__device__ __forceinline__ float packf(float v, unsigned tag, unsigned keepmask) { return __builtin_bit_cast(float, (__builtin_bit_cast(unsigned, v) & keepmask) | tag); }
#define P4_CE(a, b) do { const float _h = __builtin_amdgcn_fmed3f(a, b, P4_INF), _l = __builtin_amdgcn_fmed3f(a, b, -P4_INF); a = _h; b = _l; } while (0)
__device__ __forceinline__ void p4_sort16(float (&x)[16], const float P4_INF) {
    P4_CE(x[0], x[1]); P4_CE(x[2], x[3]); P4_CE(x[0], x[2]); P4_CE(x[1], x[3]); P4_CE(x[1], x[2]); P4_CE(x[4], x[5]); P4_CE(x[6], x[7]); P4_CE(x[4], x[6]);
    P4_CE(x[5], x[7]); P4_CE(x[5], x[6]); P4_CE(x[0], x[4]); P4_CE(x[2], x[6]); P4_CE(x[2], x[4]); P4_CE(x[1], x[5]); P4_CE(x[3], x[7]); P4_CE(x[3], x[5]);
    P4_CE(x[1], x[2]); P4_CE(x[3], x[4]); P4_CE(x[5], x[6]); P4_CE(x[8], x[9]); P4_CE(x[10], x[11]); P4_CE(x[8], x[10]); P4_CE(x[9], x[11]); P4_CE(x[9], x[10]);
    P4_CE(x[12], x[13]); P4_CE(x[14], x[15]); P4_CE(x[12], x[14]); P4_CE(x[13], x[15]); P4_CE(x[13], x[14]); P4_CE(x[8], x[12]); P4_CE(x[10], x[14]); P4_CE(x[10], x[12]);
    P4_CE(x[9], x[13]); P4_CE(x[11], x[15]); P4_CE(x[11], x[13]); P4_CE(x[9], x[10]); P4_CE(x[11], x[12]); P4_CE(x[13], x[14]); P4_CE(x[0], x[8]); P4_CE(x[4], x[12]);
    P4_CE(x[4], x[8]); P4_CE(x[2], x[10]); P4_CE(x[6], x[14]); P4_CE(x[6], x[10]); P4_CE(x[2], x[4]); P4_CE(x[6], x[8]); P4_CE(x[10], x[12]); P4_CE(x[1], x[9]);
    P4_CE(x[5], x[13]); P4_CE(x[5], x[9]); P4_CE(x[3], x[11]); P4_CE(x[7], x[15]); P4_CE(x[7], x[11]); P4_CE(x[3], x[5]); P4_CE(x[7], x[9]); P4_CE(x[11], x[13]);
    P4_CE(x[1], x[2]); P4_CE(x[3], x[4]); P4_CE(x[5], x[6]); P4_CE(x[7], x[8]); P4_CE(x[9], x[10]); P4_CE(x[11], x[12]); P4_CE(x[13], x[14]);
}
__device__ __forceinline__ void p4_bitonic16(float (&x)[16], const float P4_INF) {
    P4_CE(x[0], x[8]); P4_CE(x[1], x[9]); P4_CE(x[2], x[10]); P4_CE(x[3], x[11]); P4_CE(x[4], x[12]); P4_CE(x[5], x[13]); P4_CE(x[6], x[14]); P4_CE(x[7], x[15]);
    P4_CE(x[0], x[4]); P4_CE(x[1], x[5]); P4_CE(x[2], x[6]); P4_CE(x[3], x[7]); P4_CE(x[8], x[12]); P4_CE(x[9], x[13]); P4_CE(x[10], x[14]); P4_CE(x[11], x[15]);
    P4_CE(x[0], x[2]); P4_CE(x[1], x[3]); P4_CE(x[4], x[6]); P4_CE(x[5], x[7]); P4_CE(x[8], x[10]); P4_CE(x[9], x[11]); P4_CE(x[12], x[14]); P4_CE(x[13], x[15]);
    P4_CE(x[0], x[1]); P4_CE(x[2], x[3]); P4_CE(x[4], x[5]); P4_CE(x[6], x[7]); P4_CE(x[8], x[9]); P4_CE(x[10], x[11]); P4_CE(x[12], x[13]); P4_CE(x[14], x[15]);
}
__device__ __forceinline__ void p4_unpack8(const u32x4 s, const int cc, float* C) {
#pragma unroll
    for (int h = 0; h < 2; ++h)
#pragma unroll
        for (int j = 0; j < 4; ++j) {
            const unsigned dw = s[2 * h + (j >> 1)];
            const f16x2s v2 = __builtin_bit_cast(f16x2s, dw);
            const float v = (j & 1) ? (float)v2.y : (float)v2.x;
            C[4 * h + j] = __builtin_bit_cast(float, __builtin_bit_cast(unsigned, v) | (unsigned)(32 * (cc >> 2) + 16 * h + 4 * (cc & 3) + j));
        }
}
__device__ __forceinline__ void p4_topk_lists_lds(const LAS unsigned char* img, float (&L)[16]) {
    const int t = threadIdx.x, row = t & 255, p = t >> 8;
    float inf = __builtin_inff(); asm volatile("" : "+v"(inf));
    const LAS u32x4* sp = (const LAS u32x4*)img + p * 16 * 256 + row;
#pragma unroll
    for (int k = 0; k < 8; ++k) {
        float C[16];
        p4_unpack8(sp[(2 * k) * 256], 2 * k, C); p4_unpack8(sp[(2 * k + 1) * 256], 2 * k + 1, C + 8);
        p4_sort16(C, inf);
        if (k == 0) {
#pragma unroll
            for (int i = 0; i < 16; ++i) L[i] = C[i];
        } else {
#pragma unroll
            for (int i = 0; i < 16; ++i) L[i] = __builtin_amdgcn_fmed3f(L[i], C[15 - i], inf);
            p4_bitonic16(L, inf);
        }
    }
}
__device__ __forceinline__ void p4_topk_pairs(const float* lst, int row, const unsigned* __restrict__ scl, unsigned (&res)[48]) {
    float Av[16], Bv[16], best[16];
#pragma unroll
    for (int j = 0; j < 16; ++j) { Av[j] = packf(lst[j * 256 + row], 0u, 0xFFFFFF80u); Bv[j] = packf(lst[(16 + j) * 256 + row], 0u, 0xFFFFFF80u); best[j] = -3.0e38f; }
#pragma unroll
    for (int i = 0; i < 16; ++i)
#pragma unroll
        for (int j = 0; j < 16 / (i + 1); ++j) ins16(best, packf(Av[i] + Bv[j], (unsigned)(i * 16 + j), 0xFFFFFF00u));
#pragma unroll
    for (int r = 0; r < 16; ++r) {
        const unsigned code = __builtin_bit_cast(unsigned, best[r]) & 255u;
        const unsigned ka = __builtin_bit_cast(unsigned, lst[(code >> 4) * 256 + row]) & 127u, kb = __builtin_bit_cast(unsigned, lst[(16 + (code & 15u)) * 256 + row]) & 127u;
        res[r] = (int)(ka * NK + kb); res[17 + 2 * r] = scl[res[r]];
        res[16 + 2 * r] = __builtin_bit_cast(unsigned, best[r]) & 0xFFFFFF00u;
    }
}
constexpr int STG_PITCH = 52;
__device__ __forceinline__ void p4_stage(const unsigned (&res)[48], int row, unsigned* stg) {
#pragma unroll
    for (int k = 0; k < 12; ++k) *(u32x4*)(stg + row * STG_PITCH + 4 * k) = (u32x4){res[4 * k], res[4 * k + 1], res[4 * k + 2], res[4 * k + 3]};
}
__device__ __forceinline__ void p4_store(const unsigned* stg, int t, int row_base, int head, int* __restrict__ ids, f32x2* __restrict__ meta) {
    const int w = t >> 6, lane = t & 63;
#pragma unroll
    for (int i = 0; i < 8; ++i) { const int row = 64 * w + 8 * i + (lane >> 3), ch = lane & 7;
        *(u32x4*)((unsigned*)(meta + (size_t)(row_base + row) * 128 + head * 16) + 4 * ch) = *(const u32x4*)(stg + row * STG_PITCH + 16 + 4 * ch); }
#pragma unroll
    for (int i = 0; i < 4; ++i) { const int row = 64 * w + 16 * i + (lane >> 2), ch = lane & 3;
        *(u32x4*)((unsigned*)(ids + (size_t)(row_base + row) * 128 + head * 16) + 4 * ch) = *(const u32x4*)(stg + row * STG_PITCH + 4 * ch); }
}

__device__ __forceinline__ float gelu_exact(float v) {
    const float av = fabsf(v), t = __builtin_amdgcn_rcpf(av * 0.2316418882f + 1.0f);
    float q = t * 0.5307027145f + (-0.7265760135f); q = q * t + 0.7107068705f; q = q * t + (-0.142248368f); q = q * t + 0.127414796f; q = q * t;
    const float e = __builtin_amdgcn_exp2f(v * v * (-0.72134752044f));
    const float m = v * (q * e);
    return v < 0.f ? m : v - m;
}
constexpr int P5_WAVE_LDS = 3 * 128 * 12;
struct P5Raw { int idA, idB; f32x2 mA, mB; u32x2 hx[4]; };
__device__ __forceinline__ void p5_load(P5Raw& q, const bf16* __restrict__ h, const int* __restrict__ ids, const f32x2* __restrict__ meta, int r, int lane) {
    q.idA = ids[(size_t)r * 128 + lane]; q.idB = ids[(size_t)r * 128 + 64 + lane];
    q.mA = meta[(size_t)r * 128 + lane]; q.mB = meta[(size_t)r * 128 + 64 + lane];
    const u32x2* hr = (const u32x2*)(h + (size_t)r * D);
#pragma unroll
    for (int j = 0; j < 4; ++j) q.hx[j] = hr[lane + 64 * j];
}
__device__ __forceinline__ void p5_rank8(int kA, int kB, int& posA, int& posB) {
    int base = 0; posA = 0; posB = 0;
#pragma unroll
    for (int p = 0; p < 8; ++p) {
        const unsigned long long ba = __ballot(kA == p), bb = __ballot(kB == p);
        const int ra = __builtin_amdgcn_mbcnt_hi((unsigned)(ba >> 32), __builtin_amdgcn_mbcnt_lo((unsigned)ba, 0u));
        const int rb = __builtin_amdgcn_mbcnt_hi((unsigned)(bb >> 32), __builtin_amdgcn_mbcnt_lo((unsigned)bb, 0u));
        const int ca = __popcll(ba), cb = __popcll(bb);
        posA = (kA == p) ? base + ra : posA;
        posB = (kB == p) ? base + ca + rb : posB;
        base += ca + cb;
    }
}
constexpr int P5_LOW = 8;
__device__ __forceinline__ float p5_sort(const P5Raw& q, LAS unsigned char* wl, int buf, int lane) {
    float ssq = 0.f;
#pragma unroll
    for (int j = 0; j < 4; ++j) { const float a = bflo(q.hx[j].x), b = bfhi(q.hx[j].x), c = bflo(q.hx[j].y), d = bfhi(q.hx[j].y); ssq += a * a + b * b + c * c + d * d; }
    const float rs = 1.0f / sqrtf(wave_sum(ssq) * (1.0f / D) + EPS);
    const float ta = q.mA.x * rs, tb = q.mB.x * rs;
    float ma = ta, mb = tb;
#pragma unroll
    for (int o = 1; o < 16; o <<= 1) { ma = fmaxf(ma, __shfl_xor(ma, o)); mb = fmaxf(mb, __shfl_xor(mb, o)); }
    const float ea = __expf(ta - ma), eb = __expf(tb - mb);
    float sa = ea, sb = eb;
#pragma unroll
    for (int o = 1; o < 16; o <<= 1) { sa += __shfl_xor(sa, o); sb += __shfl_xor(sb, o); }
    const float ga = ea / sa, gb = eb / sb;
    LAS unsigned* t_so = (LAS unsigned*)(wl + 2 * 1536); LAS f32x2* t_sm = (LAS f32x2*)(wl + 2 * 1536 + 512);
    LAS unsigned* so = (LAS unsigned*)(wl + buf * 1536); LAS f32x2* sm = (LAS f32x2*)(wl + buf * 1536 + 512);
    int posA, posB;
    p5_rank8((q.idA >> P5_LOW) & 7, (q.idB >> P5_LOW) & 7, posA, posB);
    t_so[posA] = (unsigned)q.idA; t_so[posB] = (unsigned)q.idB;
    t_sm[posA] = (f32x2){ga, q.mA.y}; t_sm[posB] = (f32x2){gb, q.mB.y};
    const unsigned i2A = t_so[lane], i2B = t_so[lane + 64];
    const f32x2 m2A = t_sm[lane], m2B = t_sm[lane + 64];
    p5_rank8((int)(i2A >> (P5_LOW + 3)), (int)(i2B >> (P5_LOW + 3)), posA, posB);
    so[posA] = i2A * 512u; so[posB] = i2B * 512u;
    sm[posA] = m2A; sm[posB] = m2B;
    return rs;
}
typedef _Float16 f16x2 __attribute__((ext_vector_type(2)));
__device__ __forceinline__ void axpy16_fp4_h(const u32x2 v, const f16x2 w2, f16x2 (&acc)[8]) {
#pragma unroll
    for (int d = 0; d < 2; ++d) {
        acc[4 * d + 0] = __builtin_elementwise_fma(__builtin_bit_cast(f16x2, __builtin_amdgcn_cvt_scalef32_pk_f16_fp4(v[d], 1.0f, 0)), w2, acc[4 * d + 0]);
        acc[4 * d + 1] = __builtin_elementwise_fma(__builtin_bit_cast(f16x2, __builtin_amdgcn_cvt_scalef32_pk_f16_fp4(v[d], 1.0f, 1)), w2, acc[4 * d + 1]);
        acc[4 * d + 2] = __builtin_elementwise_fma(__builtin_bit_cast(f16x2, __builtin_amdgcn_cvt_scalef32_pk_f16_fp4(v[d], 1.0f, 2)), w2, acc[4 * d + 2]);
        acc[4 * d + 3] = __builtin_elementwise_fma(__builtin_bit_cast(f16x2, __builtin_amdgcn_cvt_scalef32_pk_f16_fp4(v[d], 1.0f, 3)), w2, acc[4 * d + 3]);
    }
}
typedef int i32x8 __attribute__((ext_vector_type(8)));
constexpr float P5_HS = 8.0f;
constexpr int P5_BIMG = 3 * 1536, P5_BLO = 1024 + 16, P5_BSZ = 2048 + 64;
constexpr int P5_WAVE_LDS2 = P5_BIMG + 2 * P5_BSZ;
__device__ __forceinline__ void p5_bimage(const u32x2 (&hx)[4], LAS unsigned char* img, int lane) {
    u32x4 bh, bl;
#pragma unroll
    for (int t = 0; t < 4; ++t) {
        const float a0 = bflo(hx[t].x) * P5_HS, a1 = bfhi(hx[t].x) * P5_HS, a2 = bflo(hx[t].y) * P5_HS, a3 = bfhi(hx[t].y) * P5_HS;
        int wv = 0;
        wv = __builtin_amdgcn_cvt_pk_fp8_f32(__builtin_amdgcn_fmed3f(a0, -440.f, 440.f), __builtin_amdgcn_fmed3f(a1, -440.f, 440.f), wv, false);
        wv = __builtin_amdgcn_cvt_pk_fp8_f32(__builtin_amdgcn_fmed3f(a2, -440.f, 440.f), __builtin_amdgcn_fmed3f(a3, -440.f, 440.f), wv, true);
        const float r0 = a0 - __builtin_amdgcn_cvt_f32_fp8(wv, 0), r1 = a1 - __builtin_amdgcn_cvt_f32_fp8(wv, 1), r2 = a2 - __builtin_amdgcn_cvt_f32_fp8(wv, 2), r3 = a3 - __builtin_amdgcn_cvt_f32_fp8(wv, 3);
        int wl2 = 0;
        wl2 = __builtin_amdgcn_cvt_pk_fp8_f32(__builtin_amdgcn_fmed3f(r0, -440.f, 440.f), __builtin_amdgcn_fmed3f(r1, -440.f, 440.f), wl2, false);
        wl2 = __builtin_amdgcn_cvt_pk_fp8_f32(__builtin_amdgcn_fmed3f(r2, -440.f, 440.f), __builtin_amdgcn_fmed3f(r3, -440.f, 440.f), wl2, true);
        bh[t] = (unsigned)wv; bl[t] = (unsigned)wl2;
    }
    *(LAS u32x4*)(img + lane * 16) = bh; *(LAS u32x4*)(img + P5_BLO + lane * 16) = bl;
}
__device__ __forceinline__ f32x4 p5_mfma(const u32x4 a, const u32x4 b0, const u32x4 b1, const f32x4 c) {
    const i32x8 bv = {(int)b0.x, (int)b0.y, (int)b0.z, (int)b0.w, (int)b1.x, (int)b1.y, (int)b1.z, (int)b1.w};
    const i32x8 av = {(int)a.x, (int)a.y, (int)a.z, (int)a.w, 0, 0, 0, 0};
    return __builtin_amdgcn_mfma_scale_f32_16x16x128_f8f6f4(av, bv, c, 4  , 0  , 0, 0x7F7F7F7F, 0, 0x7F7F7F7F);
}
__device__ __forceinline__ float p5_weight(const f32x4 dv, const f32x2 mt, const float rs, int lane) {
    float d4[4];
#pragma unroll
    for (int i = 0; i < 4; ++i) { const float di = dv[i]; d4[i] = di + __builtin_bit_cast(float, __builtin_amdgcn_mov_dpp(__builtin_bit_cast(int, di), 0xB1, 0xF, 0xF, true)); }
    const int l3 = lane & 3;
    float pd = d4[0]; pd = (l3 == 1) ? d4[1] : pd; pd = (l3 == 2) ? d4[2] : pd; pd = (l3 == 3) ? d4[3] : pd;
    const float g1 = mt.x, sc2 = mt.y;
    const unsigned scb = __builtin_bit_cast(unsigned, sc2);
    return g1 * bfhi(scb) * gelu_exact(pd * rs * bflo(scb));
}
__device__ __forceinline__ void p5_peer(const bf16* __restrict__ h, const int* __restrict__ ids, const f32x2* __restrict__ meta, const unsigned char* __restrict__ u4, const unsigned char* __restrict__ v4,
                                        const float* __restrict__ gfin, float* __restrict__ out, int gw, int ngw, int rend, int lane, LAS unsigned char* wl) {
    const __amdgpu_buffer_rsrc_t ru = __builtin_amdgcn_make_buffer_rsrc((void*)u4, (short)0, NE * 512, 0x00020000);
    const __amdgpu_buffer_rsrc_t rv = __builtin_amdgcn_make_buffer_rsrc((void*)v4, (short)0, NE * 512, 0x00020000);
    const int voff = lane * 8, uoff = 16 * (lane >> 4);
    const int boff = ((lane & 1) ? P5_BLO : 0) + 16 * (lane >> 4);
    const int mtoff = 4 * (lane >> 4) + (lane & 3);
    u32x4 A[8]; u32x2 V[16], hxn[4];
    int nid[16];
    unsigned xu;
    float rsn, w;
    {
        P5Raw q; p5_load(q, h, ids, meta, gw, lane);
        rsn = p5_sort(q, wl, 0, lane);
#pragma unroll
        for (int j = 0; j < 4; ++j) hxn[j] = q.hx[j];
        p5_bimage(hxn, wl + P5_BIMG, lane);
        const unsigned x0 = ((LAS unsigned*)wl)[lane & 15], x1 = ((LAS unsigned*)wl)[16 + (lane & 15)];
        xu = ((LAS unsigned*)wl)[32 + (lane & 15)];
#pragma unroll
        for (int c = 0; c < 8; ++c) A[c] = __builtin_amdgcn_raw_buffer_load_b128(ru, (int)x0 + uoff + 64 * c, 0, 0);
#pragma unroll
        for (int j = 0; j < 16; ++j) V[j] = __builtin_amdgcn_raw_buffer_load_b64(rv, voff, __builtin_amdgcn_readlane((int)x0, j), 0);
        f32x4 dv = {0.f, 0.f, 0.f, 0.f};
        const LAS unsigned char* bs = wl + P5_BIMG + boff;
#pragma unroll
        for (int c = 0; c < 8; ++c) {
            dv = p5_mfma(A[c], *(const LAS u32x4*)(bs + 128 * c), *(const LAS u32x4*)(bs + 128 * c + 64), dv);
            A[c] = __builtin_amdgcn_raw_buffer_load_b128(ru, (int)x1 + uoff + 64 * c, 0, 0);
        }
        w = p5_weight(dv, ((LAS f32x2*)(wl + 512))[mtoff], rsn * (1.0f / P5_HS), lane);
#pragma unroll
        for (int j = 0; j < 16; ++j) nid[j] = __builtin_amdgcn_readlane((int)x1, j);
    }
    int buf = 0;
    for (int r = gw; r < rend; r += ngw, buf ^= 1) {
        const int rnext = (r + ngw < rend) ? r + ngw : r;
        const bool last = (r + ngw >= rend);
        f32x2 acc[8]; u32x2 hcur[4];
#pragma unroll
        for (int j = 0; j < 4; ++j) hcur[j] = hxn[j];
#pragma unroll
        for (int j = 0; j < 8; ++j) acc[j] = (f32x2){0.f, 0.f};
        float rs1 = rsn * (1.0f / P5_HS);
        auto batch = [&](const int b) {
            const int e3 = (b + 3) * 16 + (lane & 15);
            unsigned x3 = ((LAS unsigned*)(wl + ((e3 >> 7) ^ buf) * 1536))[e3 & 127];
            if (last && b + 3 >= 8) x3 = 0x7F000000u;
            const int e1 = (b + 1) * 16 + mtoff;
            const f32x2 mt = ((LAS f32x2*)(wl + ((e1 >> 7) ^ buf) * 1536 + 512))[e1 & 127];
            const LAS unsigned char* bs = wl + P5_BIMG + ((((b + 1) >> 3) ^ buf) & 1) * P5_BSZ + boff;
            const int vu2 = (int)xu + uoff;
            const f16x2 wh = {(_Float16)w, (_Float16)w};
            f16x2 a16[8];
#pragma unroll
            for (int j = 0; j < 8; ++j) a16[j] = (f16x2){(_Float16)0.f, (_Float16)0.f};
            f32x4 dv = {0.f, 0.f, 0.f, 0.f};
            u32x4 B0[2], B1[2];
            B0[0] = *(const LAS u32x4*)bs; B1[0] = *(const LAS u32x4*)(bs + 64);
#pragma unroll
            for (int j = 0; j < 16; ++j) {
                if ((j & 1) == 0) {
                    const int c = j >> 1;
                    if (c + 1 < 8) { B0[(c + 1) & 1] = *(const LAS u32x4*)(bs + 128 * (c + 1)); B1[(c + 1) & 1] = *(const LAS u32x4*)(bs + 128 * (c + 1) + 64); }
                    dv = p5_mfma(A[c], B0[c & 1], B1[c & 1], dv);
                    A[c] = __builtin_amdgcn_raw_buffer_load_b128(ru, vu2 + 64 * c, 0, 0);
                    __builtin_amdgcn_sched_barrier(0);
                }
                const f16x2 wj = __builtin_bit_cast(f16x2, __builtin_amdgcn_readlane(__builtin_bit_cast(int, wh), 16 * (j >> 2) + (j & 3)));
                axpy16_fp4_h(V[j], wj, a16);
                V[j] = __builtin_amdgcn_raw_buffer_load_b64(rv, voff, nid[j], 0);
                __builtin_amdgcn_sched_barrier(0);
            }
#pragma unroll
            for (int j = 0; j < 8; ++j) { const f16x2 t = a16[j]; acc[j] += (f32x2){(float)t.x, (float)t.y}; }
            w = p5_weight(dv, mt, rs1, lane);
#pragma unroll
            for (int j = 0; j < 16; ++j) nid[j] = __builtin_amdgcn_readlane((int)xu, j);
            xu = x3;
        };
        P5Raw q; p5_load(q, h, ids, meta, rnext, lane);
        __builtin_amdgcn_sched_barrier(0);
        batch(0);
        rsn = p5_sort(q, wl, buf ^ 1, lane);
#pragma unroll
        for (int j = 0; j < 4; ++j) hxn[j] = q.hx[j];
        p5_bimage(hxn, wl + P5_BIMG + (buf ^ 1) * P5_BSZ, lane);
#pragma unroll 1
        for (int b = 1; b < 7; ++b) batch(b);
        rs1 = rsn * (1.0f / P5_HS);
        batch(7);
        float s = 0.f;
#pragma unroll
        for (int j = 0; j < 4; ++j) { acc[2 * j] += (f32x2){bflo(hcur[j].x), bfhi(hcur[j].x)}; acc[2 * j + 1] += (f32x2){bflo(hcur[j].y), bfhi(hcur[j].y)}; }
#pragma unroll
        for (int j = 0; j < 8; ++j) s += acc[j].x * acc[j].x + acc[j].y * acc[j].y;
        s = wave_sum(s);
        const float rf = 1.0f / sqrtf(s * (1.0f / D) + EPS);
        float4* orow = (float4*)(out + (size_t)r * D);
#pragma unroll
        for (int j = 0; j < 4; ++j) { const float4 gg = ((const float4*)gfin)[lane + 64 * j];
            orow[lane + 64 * j] = make_float4(acc[2 * j].x * rf * gg.x, acc[2 * j].y * rf * gg.y, acc[2 * j + 1].x * rf * gg.z, acc[2 * j + 1].y * rf * gg.w); }
    }
}

#define XB_TMO      128
#define XB_XCNT(j)  (256  + 64 * (j))
#define XB_XSUB(j)  (1280 + 64 * (j))
#define XB_XGEN(j)  (2304 + 64 * (j))
#define XB_TOP      3328
#define XB_TOPGEN   3392
#define XCD_BAR_WORDS 3456
#define XB_LSUB(j)  (3456 + 64 * (j))
#define XB_LGEN(j)  (4480 + 64 * (j))
#define XB_NCSUB(j) (5568 + 64 * (j))
#define XB_NCTOP    6592
#define XB_GSUB(x, g) (8192 + 32 * ((x) * 8 + (g)))
#define XB_GGEN(x, g) (8192 + 2048 + 32 * ((x) * 8 + (g)))
#define XB_TABDONE  5504
#define XB_SPIN_CAP (1u << 18)

__device__ __forceinline__ unsigned xb_ld(unsigned* p)              { return __hip_atomic_load(p, __ATOMIC_RELAXED, __HIP_MEMORY_SCOPE_AGENT); }
__device__ __forceinline__ unsigned xb_add(unsigned* p, unsigned v) { return __hip_atomic_fetch_add(p, v, __ATOMIC_RELAXED, __HIP_MEMORY_SCOPE_AGENT); }
__device__ __forceinline__ unsigned xb_xcc_id() { return (unsigned)__builtin_amdgcn_s_getreg((3 << 11) | 20) & 0xFu; }
#define XB_SPIN(cond, bar) do { unsigned _sp = 0; while (cond) { __builtin_amdgcn_s_sleep(1); \
    if ((++_sp & 255u) == 0u) { if (xb_ld(&(bar)[XB_TMO])) break; if (_sp > XB_SPIN_CAP) { atomicAdd(&(bar)[XB_TMO], 1u); break; } } } } while (0)

struct XcdBarrier {
    unsigned* bar; unsigned x;
    volatile LAS unsigned* st;
};

__device__ __forceinline__ XcdBarrier xcd_barrier_post(unsigned* bar, volatile LAS unsigned* st) {
    XcdBarrier b; b.bar = bar; b.x = xb_xcc_id(); b.st = st;
    if (threadIdx.x == 0) st[3] = xb_add(&bar[XB_XCNT(b.x)], 1u) + 1u;
    return b;
}
__device__ __forceinline__ void xcd_barrier_complete(unsigned* bar, unsigned x, unsigned& nloc, unsigned& nx, unsigned& uni) {
    const unsigned G = gridDim.x * gridDim.y * gridDim.z;
    unsigned sum, cnt, mine, sp = 0u;
    for (;;) {
        sum = 0u; cnt = 0u; mine = 0u; uni = 1u;
#pragma unroll
        for (unsigned j = 0; j < 16; ++j) { const unsigned c = xb_ld(&bar[XB_XCNT(j)]); sum += c; cnt += (c > 0u) ? 1u : 0u; mine = (j == x) ? c : mine;
            uni = (j < 8u ? c == G / 8u : c == 0u) ? uni : 0u; }
        if (sum == G) break;
        __builtin_amdgcn_s_sleep(1);
        if ((++sp & 255u) == 0u) { if (xb_ld(&bar[XB_TMO])) break; if (sp > XB_SPIN_CAP) { atomicAdd(&bar[XB_TMO], 1u); break; } }
    }
    nloc = mine > 0u ? mine : 1u; nx = cnt > 0u ? cnt : 1u;
}

__device__ __forceinline__ bool G8ok() { const unsigned G = gridDim.x * gridDim.y * gridDim.z; return (G % 8u) == 0u; }
__device__ __forceinline__ void xcc_local_barrier(const XcdBarrier& b) {
    asm volatile("s_waitcnt vmcnt(0)" ::: "memory");
    __syncthreads();
    if (threadIdx.x == 0) {
        unsigned* bar = b.bar;
        const unsigned nloc = b.st[0];
        const unsigned old = xb_add(&bar[XB_LSUB(b.x)], 1u);
        const unsigned gen = old / nloc;
        __builtin_amdgcn_fence(__ATOMIC_ACQUIRE, "agent");
        if (old + 1u == (gen + 1u) * nloc) xb_add(&bar[XB_LGEN(b.x)], 1u);
        else XB_SPIN(xb_ld(&bar[XB_LGEN(b.x)]) == gen, bar);
        asm volatile("s_waitcnt vmcnt(0)" ::: "memory");
    }
    __syncthreads();
}

__device__ __forceinline__ void xcc_group_barrier(const XcdBarrier& b, unsigned g) {
    asm volatile("s_waitcnt vmcnt(0)" ::: "memory");
    __syncthreads();
    if (threadIdx.x == 0) {
        unsigned* bar = b.bar;
        const unsigned old = xb_add(&bar[XB_GSUB(b.x, g)], 1u);
        const unsigned gen = old / 4u;
        __builtin_amdgcn_fence(__ATOMIC_ACQUIRE, "agent");
        if (old + 1u == (gen + 1u) * 4u) xb_add(&bar[XB_GGEN(b.x, g)], 1u);
        else XB_SPIN(xb_ld(&bar[XB_GGEN(b.x, g)]) == gen, bar);
        asm volatile("s_waitcnt vmcnt(0)" ::: "memory");
    }
    __syncthreads();
}

__device__ __forceinline__ void xcd_barrier(const XcdBarrier& b) {
    asm volatile("s_waitcnt vmcnt(0)" ::: "memory");
    __syncthreads();
    if (threadIdx.x == 0) {
        unsigned* bar = b.bar;
        __builtin_amdgcn_s_waitcnt(0);
        unsigned nloc = b.st[0], nx = b.st[1];
        if (nloc == 0u) { unsigned uni; xcd_barrier_complete(bar, b.x, nloc, nx, uni); b.st[0] = nloc; b.st[1] = nx; b.st[2] = (uni && G8ok()) ? 1u : 0u; }
        const unsigned old = xb_add(&bar[XB_XSUB(b.x)], 1u);
        const unsigned gen = old / nloc;
        if (old + 1u == (gen + 1u) * nloc) {
            __builtin_amdgcn_fence(__ATOMIC_RELEASE, "agent");
            asm volatile("s_waitcnt vmcnt(0)" ::: "memory");
            const unsigned og = xb_add(&bar[XB_TOP], 1u);
            const unsigned tg = og / nx;
            __builtin_amdgcn_fence(__ATOMIC_ACQUIRE, "agent");
            if (og + 1u == (tg + 1u) * nx) xb_add(&bar[XB_TOPGEN], 1u);
            else XB_SPIN(xb_ld(&bar[XB_TOPGEN]) == tg, bar);
            xb_add(&bar[XB_XGEN(b.x)], 1u);
            asm volatile("s_waitcnt vmcnt(0)" ::: "memory");
        } else {
            __builtin_amdgcn_fence(__ATOMIC_ACQUIRE, "agent");
            XB_SPIN(xb_ld(&bar[XB_XGEN(b.x)]) == gen, bar);
            asm volatile("s_waitcnt vmcnt(0)" ::: "memory");
        }
    }
    __syncthreads();
}

struct Params {
    const float* in[17];
    float* out;
    unsigned char* ws;
};

__global__ void __launch_bounds__(NT, 2) fwd_megakernel(Params prm) {
    extern __shared__ __attribute__((aligned(16))) unsigned char smem[];
    const float* x = prm.in[0];
    const float* norm_mix_g = prm.in[1];
    const float* w_in = prm.in[2];
    const float* conv_w = prm.in[3];
    const float* conv_b = prm.in[4];
    const float* conv_ln_g = prm.in[5];
    const float* conv_ln_b = prm.in[6];
    const float* attn_sinks = prm.in[7];
    const float* attn_out_g = prm.in[8];
    const float* conv_out_g = prm.in[9];
    const float* w_out = prm.in[10];
    const float* norm_ffn_g = prm.in[11];
    const float* peer_w_q = prm.in[12];
    const float* peer_sub_keys = prm.in[13];
    const float* peer_u = prm.in[14];
    const float* peer_v = prm.in[15];
    const float* final_norm_g = prm.in[16];
    unsigned char* ws = prm.ws;
    bf16* W1T = (bf16*)(ws + WS_W1T); bf16* W2T = (bf16*)(ws + WS_W2T); bf16* W3T = (bf16*)(ws + WS_W3T);
    float* ctab = (float*)(ws + WS_ROPE); float* stab = ctab + SEQ * 32;
    bf16* scl = (bf16*)(ws + WS_SCL);
    unsigned char* u8 = ws + WS_U8; unsigned char* v8 = ws + WS_V8;
    bf16* XN = (bf16*)(ws + WS_XN); unsigned char* MIX = ws + WS_MIX; float* rstd1 = (float*)(ws + WS_RSTD1);
    bf16* Qb = (bf16*)(ws + WS_Q); bf16* Kb = (bf16*)(ws + WS_K); bf16* Vb = (bf16*)(ws + WS_V); bf16* UB = (bf16*)(ws + WS_UB);
    bf16* HB = (bf16*)(ws + WS_HB);
    int* ids = (int*)(ws + WS_IDS); f32x2* meta = (f32x2*)(ws + WS_META);

    const int tid = threadIdx.x, lane = tid & 63, wave = __builtin_amdgcn_readfirstlane(tid >> 6);
    const int G = gridDim.x, gw = blockIdx.x * NWAVES + wave, ngw = G * NWAVES, gtid = blockIdx.x * NT + tid, gthreads = G * NT;
    LAS unsigned char* lds = (LAS unsigned char*)smem;
    volatile LAS unsigned* MISC = (volatile LAS unsigned*)(lds + MISC_OFF);
    if (tid < 16) MISC[tid] = 0u;
    __syncthreads();
    const XcdBarrier bar = xcd_barrier_post((unsigned*)(ws + WS_CTL), MISC);

    const int tab_p1 = (G == 256) ? TAB_P1 : 0;
    for (int rep = 0; rep < REP0; ++rep) {
    p0_transpose<0>(w_in, INW, INW, W1T, norm_mix_g, nullptr, gtid, gthreads);
    for (int i = gtid; i < SEQ * 32; i += gthreads) { const int pos = i >> 5, ii = i & 31;
        const float ang = (float)pos * powf(10000.0f, -(float)ii / 32.0f); ctab[i] = cosf(ang); stab[i] = sinf(ang); }
    p0_xn(x, XN, rstd1, gw, ngw, lane);
    asm volatile("s_waitcnt vmcnt(0)" ::: "memory");
    __syncthreads();
    if (tid == 0) {
        unsigned nloc = MISC[0], nx = MISC[1];
        if (nloc == 0u) { unsigned uni; xcd_barrier_complete(bar.bar, bar.x, nloc, nx, uni); MISC[0] = nloc; MISC[1] = nx; MISC[2] = (uni && G8ok()) ? 1u : 0u; }
        if (G == 256 && MISC[2] != 0u) {
            const unsigned old = xb_add(&bar.bar[XB_XSUB(bar.x)], 1u);
            if (old + 1u == nloc) {
                __builtin_amdgcn_fence(__ATOMIC_RELEASE, "agent"); asm volatile("s_waitcnt vmcnt(0)" ::: "memory");
                const unsigned og = xb_add(&bar.bar[XB_TOP], 1u);
                if (og + 1u == nx) xb_add(&bar.bar[XB_TOPGEN], 1u);
            }
        }
    }
    __syncthreads();
    const bool xl0 = (G == 256) && (MISC[2] != 0u);
    if ((blockIdx.x & 1) == 0) for (int item = blockIdx.x; item < 256; item += G) p0_fold_item(peer_w_q, peer_sub_keys, norm_ffn_g, W3T, item, (float*)smem);
    p0_transpose<1>(w_out, D, D, W2T, attn_out_g, conv_out_g, gtid, gthreads);
    p0_tab4(peer_u, norm_ffn_g, u8, scl, 0, tab_p1, NE, gw, ngw, lane);
    p0_tab4(peer_v, nullptr, v8, scl, 1, tab_p1, NE, gw, ngw, lane);
    if ((blockIdx.x & 1) != 0) for (int item = blockIdx.x; item < 256; item += G) p0_fold_item(peer_w_q, peer_sub_keys, norm_ffn_g, W3T, item, (float*)smem);
    if (xl0) {
        asm volatile("s_waitcnt vmcnt(0)" ::: "memory");
        __syncthreads();
        if (tid == 0) {
            const unsigned nloc = MISC[0];
            const unsigned old = xb_add(&bar.bar[XB_NCSUB(bar.x)], 1u);
            if (old + 1u == nloc) { __builtin_amdgcn_fence(__ATOMIC_RELEASE, "agent"); asm volatile("s_waitcnt vmcnt(0)" ::: "memory"); xb_add(&bar.bar[XB_NCTOP], 1u); }
            __builtin_amdgcn_fence(__ATOMIC_ACQUIRE, "agent");
            XB_SPIN(xb_ld(&bar.bar[XB_TOPGEN]) == 0u, bar.bar);
            asm volatile("s_waitcnt vmcnt(0)" ::: "memory");
        }
        __syncthreads();
    } else xcd_barrier(bar);
    }
    const bool xl = (G == 256) && (MISC[2] != 0u);
    const int vb = xl ? (int)((MISC[3] - 1u) * 8u + bar.x) : (int)blockIdx.x;
    const int pgrp = (vb >> 3) & 7, pqtr = vb >> 6, ppan = (vb & 7) * 8 + pgrp;

    for (int rep = 0; rep < REP1; ++rep) {
        pg8::Gemm g{XN, W1T, M, INW, D}; pg8::StaticOrder S; S.init(M, INW, G, vb);
        EpiProj E{Qb, Kb, Vb, UB, ctab, stab, rstd1};
        pg8::gemm_phase<EpiProj, pg8::StaticOrder, true, true>(lds, g, S, E);
        if (G == 256 && vb >= 192) {
            const int gw1 = (vb - 192) * NWAVES + wave;
            p0_tab4(peer_u, norm_ffn_g, u8, scl, 0, 0, TAB_P1, gw1, 64 * NWAVES, lane);
            p0_tab4(peer_v, nullptr, v8, scl, 1, 0, TAB_P1, gw1, 64 * NWAVES, lane);
            if (xl) {
                asm volatile("s_waitcnt vmcnt(0)" ::: "memory");
                __syncthreads();
                if (tid == 0) { __builtin_amdgcn_fence(__ATOMIC_RELEASE, "agent"); asm volatile("s_waitcnt vmcnt(0)" ::: "memory"); xb_add(&bar.bar[XB_TABDONE], 1u); }
            }
        }
        if (xl) xcc_local_barrier(bar); else xcd_barrier(bar);
    }

    for (int rep = 0; rep < REP2; ++rep) {
    for (int i = vb; i < M / 64; i += G) { const int u = xl ? 4 * ppan + pqtr : (G % 8 == 0 && (M / 64) % 8 == 0) ? (i & 7) * (M / 64 / 8) + (i >> 3) : i; p2_attn_unit(Qb, Kb, Vb, attn_sinks, MIX, u, lds); }
    {
        float cwr[CK][2]; const int cp = tid & 255;
#pragma unroll
        for (int j = 0; j < CK; ++j) { const f32x2 w2 = *(const f32x2*)(conv_w + j * CC + 2 * cp); cwr[j][0] = w2[0]; cwr[j][1] = w2[1]; }
        const f32x2 cb2 = *(const f32x2*)(conv_b + 2 * cp);
        for (int i = vb; i < M / 32; i += G) { const int u = xl ? 8 * ppan + 2 * pqtr + (i >= G ? 1 : 0) : (G % 8 == 0) ? (i & 7) * (M / 32 / 8) + (i >> 3) : i; p2_conv_unit(UB, cwr, cb2[0], cb2[1], conv_ln_g, conv_ln_b, MIX, u, (float*)smem); }
    }
    if (xl) { if (tid == 0) XB_SPIN(xb_ld(&bar.bar[XB_NCTOP]) < MISC[1], bar.bar);
              xcc_group_barrier(bar, (unsigned)pgrp); }
    else xcd_barrier(bar);
    }

    for (int rep = 0; rep < REP3; ++rep) {
        pg8::Gemm g{(const bf16*)MIX, W2T, M, D, D / 2}; pg8::StaticOrder S; S.init(M, D, G, vb);
        EpiRes E{XN, HB, ws + WS_HB8};
        pg8::gemm_phase<EpiRes, pg8::StaticOrder, true, true, true>(lds, g, S, E);
        if (xl) { if (tid == 0) XB_SPIN(xb_ld(&bar.bar[XB_TABDONE]) < 64u, bar.bar);
                  xcc_group_barrier(bar, (unsigned)pgrp); }
        else xcd_barrier(bar);
    }

    for (int rep = 0; rep < REP4; ++rep) {
        const int sb = __builtin_amdgcn_readfirstlane((int)blockIdx.x);
        float* lst0g = (float*)(ws + WS_SC) + (size_t)sb * (32 * 256);
        pg8::Gemm g{(const bf16*)(ws + WS_HB8), W3T, M, 2048, D / 2}; pg8::StaticOrder S; S.init(M, 2048, G, vb);
        pg8::Unit u0, u1;
        const bool h0 = S.next(0, u0), h1 = S.next(1, u1);
        float* lst = (float*)smem;
#pragma unroll 1
        for (int k = 0; k < 2; ++k) {
            RoundOrder R{S, k}; EpiScoreLds E;
            pg8::gemm_phase<EpiScoreLds, RoundOrder, true, true, true>(lds, g, R, E);
            __syncthreads();
            int tq = threadIdx.x; asm volatile("" : "+v"(tq));
            const int li = (tq >> 8) * 16 * 256 + (tq & 255);
            float L[16];
            p4_topk_lists_lds(lds, L);
            __syncthreads();
            if (k == 0) {
#pragma unroll
                for (int j = 0; j < 16; ++j) lst0g[li + j * 256] = L[j];
            } else {
#pragma unroll
                for (int j = 0; j < 16; ++j) lst[32 * 256 + li + j * 256] = L[j];
#pragma unroll
                for (int j = 0; j < 16; ++j) lst[li + j * 256] = lst0g[li + j * 256];
            }
        }
        __syncthreads();
        unsigned res[48];
        const int hf = tid >> 8, tr = tid & 255;
        if (hf == 0) { if (h0) p4_topk_pairs(lst, tr, (const unsigned*)scl, res); }
        else         { if (h1) p4_topk_pairs(lst + 32 * 256, tr, (const unsigned*)scl, res); }
        __syncthreads();
        unsigned* stg = (unsigned*)smem + hf * (256 * STG_PITCH);
        if (hf == 0 ? h0 : h1) p4_stage(res, tr, stg);
        __syncthreads();
        if (hf == 0) { if (h0) p4_store(stg, tr, u0.pm * 256, u0.pn, ids, meta); }
        else         { if (h1) p4_store(stg, tr, u1.pm * 256, u1.pn, ids, meta); }
        __syncthreads();
        if (xl) xcc_group_barrier(bar, (unsigned)pgrp); else xcd_barrier(bar);
    }

    for (int rep = 0; rep < REP5; ++rep) {
        int tid5 = threadIdx.x; asm volatile("" : "+v"(tid5));
        const int lane5 = tid5 & 63, wave5 = __builtin_amdgcn_readfirstlane(tid5 >> 6);
        const int t5 = 256 * ppan + 64 * pqtr;
        const int gw5 = xl ? t5 + wave5 : (int)blockIdx.x * NWAVES + wave5;
        p5_peer(HB, ids, meta, u8, v8, final_norm_g, prm.out, gw5, xl ? NWAVES : ngw, xl ? t5 + 64 : M, lane5, lds + wave5 * P5_WAVE_LDS2);
    }
}

extern "C" void kernel_launch(void* const* d_in, const int* in_sizes, int n_in, void* d_out, int out_size, void* d_ws, size_t ws_size, hipStream_t stream) {
    static int grid_blocks = 0;
    if (!grid_blocks) {
        int dev = 0, cus = 0, per_cu = 0;
        hipGetDevice(&dev);
        hipDeviceGetAttribute(&cus, hipDeviceAttributeMultiprocessorCount, dev);
        hipFuncSetAttribute((const void*)fwd_megakernel, hipFuncAttributeMaxDynamicSharedMemorySize, LDS_BYTES);
        hipOccupancyMaxActiveBlocksPerMultiprocessor(&per_cu, (const void*)fwd_megakernel, NT, LDS_BYTES);
        if (per_cu < 1) per_cu = 1;
        grid_blocks = cus * per_cu;
        fprintf(stderr, "grid: %d CUs x %d per CU, ws %zu\n", cus, per_cu, ws_size);
    }
    hipMemsetAsync((char*)d_ws + WS_CTL, 0, CTL_ZERO_BYTES, stream);
    Params p{};
    for (int i = 0; i < 17; ++i) p.in[i] = (const float*)d_in[i];
    p.out = (float*)d_out; p.ws = (unsigned char*)d_ws;
    void* args[] = {&p};
    hipError_t e = hipLaunchCooperativeKernel((const void*)fwd_megakernel, dim3(grid_blocks), dim3(NT), args, LDS_BYTES, stream);
    if (e != hipSuccess) fprintf(stderr, "cooperative launch failed: %s (grid %d)\n", hipGetErrorString(e), grid_blocks);
}
```
